# Optimizing an MI355X kernel written in HIP

```python
import math
import jax, jax.numpy as jnp
from jax import lax
import numpy as np

D_MODEL = 2048
BATCH = 1
SEQ = 8192
DEPTH = 4

N_MIXERS = 3
N_HEADS = 32
N_KV_HEADS = 4
HEAD_DIM = 64
QKV_WIDTH = (N_HEADS + 2 * N_KV_HEADS) * HEAD_DIM
WINDOW = 128
BLOCK = 128
PAD_POS = -(1 << 20)
LRU_WIDTH = D_MODEL
N_GATE_BLOCKS = 8
GATE_BLOCK = LRU_WIDTH // N_GATE_BLOCKS
CONV_WIDTH = 4
LRU_C = 8.0
SSM_WIDTH = D_MODEL
SSM_GROUP = 16
N_SSM_GROUPS = SSM_WIDTH // SSM_GROUP
SSM_STATE = 64
DT_MIN = 0.001
DT_MAX = 0.1
D_FF = 4 * D_MODEL
PLE_DIM = 256
EPS = 1e-6

kernel_name = 'hybrid_swa_rglru_s5_trunk'


def _rmsnorm(x, gain):
    xf = x.astype(jnp.float32)
    y = xf * lax.rsqrt(jnp.mean(xf * xf, axis=-1, keepdims=True) + EPS)
    return (y * gain.astype(jnp.float32)).astype(x.dtype)


def _alibi_slopes():
    return jnp.asarray(2.0 ** (-8.0 * np.arange(1, N_HEADS + 1) / N_HEADS), dtype=jnp.float32)


def _band(a, fill):
    B, T = a.shape[0], a.shape[1]
    nb = T // BLOCK
    ab = a.reshape((B, nb, BLOCK) + a.shape[2:])
    prev = jnp.concatenate([jnp.full_like(ab[:, :1], fill), ab[:, :-1]], axis=1)
    return jnp.concatenate([prev, ab], axis=2)


def sliding_window_attention(h, positions, w_qkv, q_norm, k_norm, sinks, w_o):
    B, T, _ = h.shape
    nb = T // BLOCK
    G = N_HEADS // N_KV_HEADS
    qkv = h @ w_qkv
    q, k, v = jnp.split(qkv, [N_HEADS * HEAD_DIM, (N_HEADS + N_KV_HEADS) * HEAD_DIM], axis=-1)
    q = _rmsnorm(q.reshape(B, T, N_KV_HEADS, G, HEAD_DIM), q_norm)
    k = _rmsnorm(k.reshape(B, T, N_KV_HEADS, HEAD_DIM), k_norm)
    v = v.reshape(B, T, N_KV_HEADS, HEAD_DIM)
    qb = q.reshape(B, nb, BLOCK, N_KV_HEADS, G, HEAD_DIM)
    kb = _band(k, 0)
    vb = _band(v, 0)
    kpos = _band(positions, PAD_POS)
    qpos = positions.reshape(B, nb, BLOCK)
    dist = qpos[:, :, :, None] - kpos[:, :, None, :]
    valid = (dist >= 0) & (dist < WINDOW)
    s = jnp.einsum('bnqhgd,bnkhd->bnhgqk', qb, kb).astype(jnp.float32) * (HEAD_DIM ** -0.5)
    slopes = _alibi_slopes().reshape(N_KV_HEADS, G)
    s = s - slopes[None, None, :, :, None, None] * dist[:, :, None, None].astype(jnp.float32)
    s = jnp.where(valid[:, :, None, None], s, -jnp.inf)
    sink = jnp.broadcast_to(sinks.astype(jnp.float32).reshape(1, 1, N_KV_HEADS, G, 1, 1), s.shape[:-1] + (1,))
    prob = jax.nn.softmax(jnp.concatenate([s, sink], axis=-1), axis=-1)[..., :-1]
    o = jnp.einsum('bnhgqk,bnkhd->bnqhgd', prob.astype(v.dtype), vb)
    return o.reshape(B, T, N_HEADS * HEAD_DIM) @ w_o


def _causal_depthwise_conv(x, w, b):
    y = lax.conv_general_dilated(x, w[:, None, :], window_strides=(1,), padding=[(CONV_WIDTH - 1, 0)],
                                 dimension_numbers=('NWC', 'WIO', 'NWC'), feature_group_count=x.shape[-1])
    return y + b


def _linear_scan(a, b):
    def combine(l, r):
        a_l, b_l = l
        a_r, b_r = r
        return a_l * a_r, a_r * b_l + b_r
    _, hs = lax.associative_scan(combine, (a, b), axis=1)
    return hs


def rg_lru_block(h, w_in, conv_w, conv_b, w_gate_a, b_gate_a, w_gate_x, b_gate_x, lru_lambda, w_o):
    B, T, _ = h.shape
    xb, gb = jnp.split(h @ w_in, 2, axis=-1)
    gate = jax.nn.gelu(gb, approximate=True)
    xb = _causal_depthwise_conv(xb, conv_w, conv_b)
    xblk = xb.reshape(B, T, N_GATE_BLOCKS, GATE_BLOCK)
    r = jax.nn.sigmoid(jnp.einsum('btnw,nwv->btnv', xblk, w_gate_a).reshape(B, T, LRU_WIDTH) + b_gate_a)
    i = jax.nn.sigmoid(jnp.einsum('btnw,nwv->btnv', xblk, w_gate_x).reshape(B, T, LRU_WIDTH) + b_gate_x)
    log_a = -LRU_C * r.astype(jnp.float32) * jax.nn.softplus(-lru_lambda.astype(jnp.float32))
    a = jnp.exp(log_a)
    mult = jnp.sqrt(-jnp.expm1(2.0 * log_a))
    hs = _linear_scan(a, mult * (i * xb).astype(jnp.float32))
    return (hs.astype(h.dtype) * gate) @ w_o


def s5_block(h, w_in, a_re, a_im, log_dt, b_re, b_im, c_re, c_im, d_skip, w_glu):
    B, T, _ = h.shape
    f32 = jnp.float32
    u = (h @ w_in).reshape(B, T, N_SSM_GROUPS, SSM_GROUP).astype(f32)
    lr = a_re.astype(f32)
    li = a_im.astype(f32)
    dt = jnp.exp(log_dt.astype(f32))[:, None]
    mag = jnp.exp(lr * dt)
    abar_re = mag * jnp.cos(li * dt)
    abar_im = mag * jnp.sin(li * dt)
    n_re = abar_re - 1.0
    n_im = abar_im
    den = lr * lr + li * li
    z_re = (n_re * lr + n_im * li) / den
    z_im = (n_im * lr - n_re * li) / den
    br = b_re.astype(f32)
    bi = b_im.astype(f32)
    bbar_re = z_re[:, :, None] * br - z_im[:, :, None] * bi
    bbar_im = z_re[:, :, None] * bi + z_im[:, :, None] * br
    bu_re = jnp.einsum('btgi,gpi->btgp', u, bbar_re)
    bu_im = jnp.einsum('btgi,gpi->btgp', u, bbar_im)
    A_re = jnp.broadcast_to(abar_re, bu_re.shape)
    A_im = jnp.broadcast_to(abar_im, bu_im.shape)

    def combine(l, r):
        ar_l, ai_l, sr_l, si_l = l
        ar_r, ai_r, sr_r, si_r = r
        return (ar_r * ar_l - ai_r * ai_l,
                ar_r * ai_l + ai_r * ar_l,
                ar_r * sr_l - ai_r * si_l + sr_r,
                ar_r * si_l + ai_r * sr_l + si_r)

    _, _, s_re, s_im = lax.associative_scan(combine, (A_re, A_im, bu_re, bu_im), axis=1)
    y = (jnp.einsum('btgp,gip->btgi', s_re, c_re.astype(f32))
         - jnp.einsum('btgp,gip->btgi', s_im, c_im.astype(f32))
         + d_skip.astype(f32).reshape(N_SSM_GROUPS, SSM_GROUP) * u)
    g = jax.nn.gelu(y.reshape(B, T, SSM_WIDTH).astype(h.dtype))
    val, gt = jnp.split(g @ w_glu, 2, axis=-1)
    return val * jax.nn.sigmoid(gt)


def _squared_relu_mlp(h, w_up, w_down):
    return jnp.square(jax.nn.relu(h @ w_up)) @ w_down


def setup_inputs(seed: int = 0) -> dict:
    key = jax.random.key(seed)
    keys = iter(jax.random.split(key, 128))
    f32 = jnp.float32

    def dense(shape, fan_in):
        return jax.random.normal(next(keys), shape, f32) * fan_in ** -0.5

    def gain(n):
        return 1.0 + 0.02 * jax.random.normal(next(keys), (n,), f32)

    def small(shape):
        return 0.01 * jax.random.normal(next(keys), shape, f32)

    inp = {}
    inp['x'] = jax.random.normal(next(keys), (BATCH, SEQ, D_MODEL), f32)
    inp['p'] = jax.random.normal(next(keys), (DEPTH, BATCH, SEQ, PLE_DIM), f32)
    inp['positions'] = jnp.broadcast_to(jnp.arange(SEQ, dtype=jnp.int32), (BATCH, SEQ))
    for i in range(DEPTH):
        pre = 'l%d_' % i
        kind = i % N_MIXERS
        inp[pre + 'mix_norm'] = gain(D_MODEL)
        if kind == 0:
            inp[pre + 'w_qkv'] = dense((D_MODEL, QKV_WIDTH), D_MODEL)
            inp[pre + 'q_norm'] = gain(HEAD_DIM)
            inp[pre + 'k_norm'] = gain(HEAD_DIM)
            inp[pre + 'sinks'] = jax.random.normal(next(keys), (N_HEADS,), f32)
            inp[pre + 'w_o'] = dense((N_HEADS * HEAD_DIM, D_MODEL), N_HEADS * HEAD_DIM)
        elif kind == 1:
            inp[pre + 'w_in'] = dense((D_MODEL, 2 * LRU_WIDTH), D_MODEL)
            inp[pre + 'conv_w'] = dense((CONV_WIDTH, LRU_WIDTH), CONV_WIDTH)
            inp[pre + 'conv_b'] = small((LRU_WIDTH,))
            inp[pre + 'w_gate_a'] = dense((N_GATE_BLOCKS, GATE_BLOCK, GATE_BLOCK), GATE_BLOCK)
            inp[pre + 'b_gate_a'] = small((LRU_WIDTH,))
            inp[pre + 'w_gate_x'] = dense((N_GATE_BLOCKS, GATE_BLOCK, GATE_BLOCK), GATE_BLOCK)
            inp[pre + 'b_gate_x'] = small((LRU_WIDTH,))
            a0 = jax.random.uniform(next(keys), (LRU_WIDTH,), f32, 0.9, 0.999)
            inp[pre + 'lru_lambda'] = jnp.log(a0) - jnp.log1p(-a0)
            inp[pre + 'w_o'] = dense((LRU_WIDTH, D_MODEL), LRU_WIDTH)
        else:
            inp[pre + 'w_in'] = dense((D_MODEL, SSM_WIDTH), D_MODEL)
            inp[pre + 'a_re'] = -0.5 + small((N_SSM_GROUPS, SSM_STATE))
            inp[pre + 'a_im'] = jnp.pi * jnp.arange(SSM_STATE, dtype=f32)[None, :] + small((N_SSM_GROUPS, SSM_STATE))
            inp[pre + 'log_dt'] = jax.random.uniform(next(keys), (N_SSM_GROUPS,), f32, math.log(DT_MIN), math.log(DT_MAX))
            inp[pre + 'b_re'] = dense((N_SSM_GROUPS, SSM_STATE, SSM_GROUP), 2 * SSM_GROUP)
            inp[pre + 'b_im'] = dense((N_SSM_GROUPS, SSM_STATE, SSM_GROUP), 2 * SSM_GROUP)
            inp[pre + 'c_re'] = dense((N_SSM_GROUPS, SSM_GROUP, SSM_STATE), SSM_STATE)
            inp[pre + 'c_im'] = dense((N_SSM_GROUPS, SSM_GROUP, SSM_STATE), SSM_STATE)
            inp[pre + 'd_skip'] = jax.random.normal(next(keys), (SSM_WIDTH,), f32)
            inp[pre + 'w_glu'] = dense((SSM_WIDTH, 2 * D_MODEL), SSM_WIDTH)
        inp[pre + 'mlp_norm'] = gain(D_MODEL)
        inp[pre + 'w_up'] = dense((D_MODEL, D_FF), D_MODEL)
        inp[pre + 'w_down'] = dense((D_FF, D_MODEL), D_FF)
        inp[pre + 'ple_norm'] = gain(D_MODEL)
        inp[pre + 'w_ple_gate'] = dense((D_MODEL, D_MODEL), D_MODEL)
        inp[pre + 'w_ple'] = dense((PLE_DIM, D_MODEL), PLE_DIM)
    return inp


def reference(x, p, positions,
              l0_mix_norm, l0_w_qkv, l0_q_norm, l0_k_norm, l0_sinks, l0_w_o,
              l0_mlp_norm, l0_w_up, l0_w_down, l0_ple_norm, l0_w_ple_gate, l0_w_ple,
              l1_mix_norm, l1_w_in, l1_conv_w, l1_conv_b, l1_w_gate_a, l1_b_gate_a, l1_w_gate_x, l1_b_gate_x,
              l1_lru_lambda, l1_w_o,
              l1_mlp_norm, l1_w_up, l1_w_down, l1_ple_norm, l1_w_ple_gate, l1_w_ple,
              l2_mix_norm, l2_w_in, l2_a_re, l2_a_im, l2_log_dt, l2_b_re, l2_b_im, l2_c_re, l2_c_im, l2_d_skip,
              l2_w_glu,
              l2_mlp_norm, l2_w_up, l2_w_down, l2_ple_norm, l2_w_ple_gate, l2_w_ple,
              l3_mix_norm, l3_w_qkv, l3_q_norm, l3_k_norm, l3_sinks, l3_w_o,
              l3_mlp_norm, l3_w_up, l3_w_down, l3_ple_norm, l3_w_ple_gate, l3_w_ple):
    layers = [
        (l0_mix_norm, (l0_w_qkv, l0_q_norm, l0_k_norm, l0_sinks, l0_w_o),
         l0_mlp_norm, l0_w_up, l0_w_down, l0_ple_norm, l0_w_ple_gate, l0_w_ple),
        (l1_mix_norm, (l1_w_in, l1_conv_w, l1_conv_b, l1_w_gate_a, l1_b_gate_a, l1_w_gate_x, l1_b_gate_x,
                       l1_lru_lambda, l1_w_o),
         l1_mlp_norm, l1_w_up, l1_w_down, l1_ple_norm, l1_w_ple_gate, l1_w_ple),
        (l2_mix_norm, (l2_w_in, l2_a_re, l2_a_im, l2_log_dt, l2_b_re, l2_b_im, l2_c_re, l2_c_im, l2_d_skip,
                       l2_w_glu),
         l2_mlp_norm, l2_w_up, l2_w_down, l2_ple_norm, l2_w_ple_gate, l2_w_ple),
        (l3_mix_norm, (l3_w_qkv, l3_q_norm, l3_k_norm, l3_sinks, l3_w_o),
         l3_mlp_norm, l3_w_up, l3_w_down, l3_ple_norm, l3_w_ple_gate, l3_w_ple),
    ]
    h = x
    for i in range(DEPTH):
        mix_norm, mix_params, mlp_norm, w_up, w_down, ple_norm, w_ple_gate, w_ple = layers[i]
        hn = _rmsnorm(h, mix_norm)
        kind = i % N_MIXERS
        if kind == 0:
            mixed = sliding_window_attention(hn, positions, *mix_params)
        elif kind == 1:
            mixed = rg_lru_block(hn, *mix_params)
        else:
            mixed = s5_block(hn, *mix_params)
        h = h + mixed
        h = h + _squared_relu_mlp(_rmsnorm(h, mlp_norm), w_up, w_down)
        h = h + (p[i] @ w_ple) * jax.nn.sigmoid(_rmsnorm(h, ple_norm) @ w_ple_gate)
    return h
```

```cpp
#include <hip/hip_runtime.h>
#include <hip/hip_cooperative_groups.h>
#include <cstdio>
#include <cstdint>
namespace cg = cooperative_groups;

#ifndef USE_XCD_BARRIER
#define USE_XCD_BARRIER 1
#endif

#define GAS __attribute__((address_space(1)))
#define LAS __attribute__((address_space(3)))
typedef unsigned short bf16_t;
typedef short bf16x8 __attribute__((ext_vector_type(8)));
typedef float f32x4 __attribute__((ext_vector_type(4)));
typedef float f32x2 __attribute__((ext_vector_type(2)));
typedef unsigned u32x4 __attribute__((ext_vector_type(4)));
typedef unsigned u32x2 __attribute__((ext_vector_type(2)));

constexpr int T = 8192, D = 2048, DFF = 8192, NQKV = 2560, PLE = 256;
constexpr float EPS = 1e-6f;
constexpr int PAD_POS = -(1 << 20);
constexpr int NWAVES = 8, NTHR = 512;

typedef __bf16 bf16v2_t __attribute__((ext_vector_type(2)));
__device__ __forceinline__ unsigned cvt_pk_bf16(float lo, float hi) { bf16v2_t v; v.x = (__bf16)lo; v.y = (__bf16)hi; return __builtin_bit_cast(unsigned, v); }
__device__ __forceinline__ float bf2f(unsigned short b) { return __builtin_bit_cast(float, (unsigned)b << 16); }
__device__ __forceinline__ float bflo(unsigned w) { return __builtin_bit_cast(float, w << 16); }
__device__ __forceinline__ float bfhi(unsigned w) { return __builtin_bit_cast(float, w & 0xffff0000u); }
__device__ __forceinline__ float sigmoidf_(float x) { return __builtin_amdgcn_rcpf(1.0f + __expf(-x)); }
__device__ __forceinline__ float gelu_tanh(float x) { const float z = 0.7978845608028654f * (x + 0.044715f * x * x * x); return x * __builtin_amdgcn_rcpf(1.0f + __expf(-2.0f * z)); }
__device__ __forceinline__ float shx(float v, int o, int lane) { return __builtin_bit_cast(float, __builtin_amdgcn_ds_bpermute((lane ^ o) << 2, __builtin_bit_cast(int, v))); }
__device__ __forceinline__ float wave_sum(float v, int lane) {
#pragma unroll
    for (int o = 1; o < 64; o <<= 1) v += shx(v, o, lane);
    return v;
}
#define LDS_WAIT() asm volatile("s_waitcnt lgkmcnt(0)" ::: "memory")
__device__ __forceinline__ int launder(int v) { asm volatile("" : "+v"(v)); return v; }
__device__ __forceinline__ int launder_s(int v) { asm volatile("" : "+s"(v)); return v; }

namespace pg8 {
constexpr int BM = 256, BK = 64, HALF = 128, HTB = HALF * BK * 2, STAGE_BYTES = 8 * HTB, NXCD = 8, WGM = 8;
__host__ __device__ __forceinline__ int lds_byte(int r, int c) { const int st = (r >> 4) * 2 + (c >> 5), rr = r & 15, cc = c & 31, ob = rr * 64 + cc * 2; return st * 1024 + (ob ^ (((ob >> 9) & 1) << 5)); }
__host__ __device__ __forceinline__ void stage_rc(int b, int& R, int& C) { const int st = b / 1024, sb = b % 1024, swz = sb ^ (((sb >> 9) & 1) << 5); R = (st >> 1) * 16 + swz / 64; C = (st & 1) * 32 + (swz % 64) / 2; }
__host__ __device__ __forceinline__ int perm32(int rho) { const int n = rho >> 4, i = rho & 15; return 8 * (i >> 2) + 4 * n + (i & 3); }

struct Unit { int pm, pn; };
struct Gemm { const bf16_t* A; const bf16_t* Bt; int M, N, K, lda, ldb, acol_shift, acol_mul; };

struct StaticOrder {
    int nM, nN, nwg, G, c;
    __device__ void init(int M, int N, int G_, int c_) { nM = M / BM; nN = N / BM; nwg = nM * nN; G = launder_s(G_); c = launder_s(c_); }
    __device__ bool next(int i, Unit& u) const {
        const long L = (long)i * G + c; if (L >= nwg) return false;
        int wgid = (int)L; { const int q = nwg / NXCD, r = nwg % NXCD, xcd = wgid % NXCD, off = wgid / NXCD; wgid = (xcd < r ? xcd * (q + 1) : r * (q + 1) + (xcd - r) * q) + off; }
        const int nig = WGM * nN, gid = wgid / nig, fm = gid * WGM, gsz = (nM - fm) < WGM ? (nM - fm) : WGM;
        u.pm = fm + ((wgid % nig) % gsz); u.pn = (wgid % nig) / gsz; return true;
    }
};

__device__ __forceinline__ float row_rstd(const float* ssq, int row) {
    const f32x4* p = (const f32x4*)(ssq + (size_t)row * 16); const f32x4 a = p[0], b = p[1], c = p[2], d = p[3];
    return rsqrtf(((((a[0] + a[1]) + (a[2] + a[3])) + ((b[0] + b[1]) + (b[2] + b[3]))) + (((c[0] + c[1]) + (c[2] + c[3])) + ((d[0] + d[1]) + (d[2] + d[3])))) * (1.0f / 2048.0f) + 1e-6f);
}
template <bool SIXTEEN> __device__ __forceinline__ void tile_ssq(const float (&s)[2][4], const Unit& u, int wr, int wc, int fr, int fq, float* ssq, LAS float* ptab) {
    const int lane = fq * 16 + fr;
#pragma unroll
    for (int ai = 0; ai < 2; ++ai)
#pragma unroll
        for (int m = 0; m < 4; ++m) { float v = s[ai][m]; v += shx(v, 16, lane); v += shx(v, 32, lane); if (fq == 0) ptab[(ai * HALF + wr * 64 + m * 16 + fr) * 4 + wc] = v; }
    asm volatile("s_waitcnt lgkmcnt(0)" ::: "memory"); __builtin_amdgcn_s_barrier(); asm volatile("" ::: "memory");
    const int t = wr * 256 + wc * 64 + lane;
    if (t < 256) { const f32x4 p = *(const LAS f32x4*)(ptab + t * 4); float* q = ssq + (size_t)(u.pm * BM + t) * 16 + u.pn; q[0] = (p[0] + p[1]) + (p[2] + p[3]); if (!SIXTEEN) q[8] = 0.f; }
}
__device__ __forceinline__ void rows_rstd(const float* ssq, int row0  , int fr, int fq, float (&rs)[8]) {
    const int lane = fq * 16 + fr; f32x4 p[8];
    const float* b0 = ssq + (size_t)row0 * 16 + fq * 4;
#pragma unroll
    for (int r = 0; r < 8; ++r) p[r] = *(const f32x4*)(b0 + (r >> 2) * (HALF * 16) + (r & 3) * 256);
#pragma unroll
    for (int r = 0; r < 8; ++r) { float v = (p[r][0] + p[r][1]) + (p[r][2] + p[r][3]); v += shx(v, 16, lane); v += shx(v, 32, lane); rs[r] = rsqrtf(v * (1.0f / 2048.0f) + 1e-6f); }
}
__device__ __forceinline__ float ssq4(const f32x4 o) { return (o[0] * o[0] + o[1] * o[1]) + (o[2] * o[2] + o[3] * o[3]); }

template <int ACT  > struct EpiBf16 {
    static constexpr bool PERM = true;
    bf16_t* O; int ldc; const float* ssq;
    __device__ __forceinline__ void operator()(f32x4 (&acc)[2][2][4][2], const Unit& u, int wr, int wc, int fr, int fq) const {
        const int row0 = u.pm * BM + wr * 64 + fr; const int col0 = u.pn * BM + wc * 32 + 8 * fq;
        float rsv[8]; if (ssq) rows_rstd(ssq, row0, fr, fq, rsv);
#pragma unroll
        for (int ai = 0; ai < 2; ++ai)
#pragma unroll
            for (int m = 0; m < 4; ++m) { const int row = row0 + ai * HALF + m * 16; bf16_t* rowp = O + (size_t)row * ldc + col0;
                const float rs = ssq ? rsv[ai * 4 + m] : 1.0f;
#pragma unroll
                for (int bj = 0; bj < 2; ++bj) { f32x4 v0 = acc[ai][bj][m][0] * rs, v1 = acc[ai][bj][m][1] * rs;
                    if (ACT == 2) {
#pragma unroll
                        for (int j = 0; j < 4; ++j) { float a = v0[j] > 0.f ? v0[j] : 0.f; v0[j] = a * a; float b = v1[j] > 0.f ? v1[j] : 0.f; v1[j] = b * b; } }
                    u32x4 w; w.x = cvt_pk_bf16(v0[0], v0[1]); w.y = cvt_pk_bf16(v0[2], v0[3]); w.z = cvt_pk_bf16(v1[0], v1[1]); w.w = cvt_pk_bf16(v1[2], v1[3]);
                    *(u32x4*)(rowp + bj * HALF) = w; } }
    }
};
struct EpiF32 {
    static constexpr bool PERM = false;
    float* O; int ldc; const float* ssq;
    __device__ __forceinline__ void operator()(f32x4 (&acc)[2][2][4][2], const Unit& u, int wr, int wc, int fr, int fq) const {
        const int col0 = u.pn * BM + wc * 32 + 4 * fq;
        float rsv[8]; if (ssq) rows_rstd(ssq, u.pm * BM + wr * 64 + fr, fr, fq, rsv);
#pragma unroll
        for (int ai = 0; ai < 2; ++ai)
#pragma unroll
            for (int m = 0; m < 4; ++m) { const int row = u.pm * BM + ai * HALF + wr * 64 + m * 16 + fr; const size_t off = (size_t)row * ldc + col0;
                const float rs = ssq ? rsv[ai * 4 + m] : 1.0f;
#pragma unroll
                for (int bj = 0; bj < 2; ++bj)
#pragma unroll
                    for (int n = 0; n < 2; ++n) *(f32x4*)(O + off + bj * HALF + n * 16) = acc[ai][bj][m][n] * rs; }
    }
};
#define EPI_ROW(r) (u.pm * BM + ((r) >> 2) * HALF + wr * 64 + ((r) & 3) * 16 + fr)
struct EpiResidual {
    static constexpr bool PERM = true;
    const float* base; float* out; bf16_t* hb; float* ssq; LAS float* ptab; const float* ssq_scale;
    __device__ __forceinline__ void operator()(f32x4 (&acc)[2][2][4][2], const Unit& u, int wr, int wc, int fr, int fq) const {
        const int col0 = u.pn * BM + wc * 32 + 8 * fq;
        float s[2][4];
        if (ssq_scale) { float rsv[8]; rows_rstd(ssq_scale, u.pm * BM + wr * 64 + fr, fr, fq, rsv);
#pragma unroll
            for (int r = 0; r < 8; ++r) { const float rs2 = rsv[r] * rsv[r];
#pragma unroll
                for (int c = 0; c < 4; ++c) acc[r >> 2][c >> 1][r & 3][c & 1] = acc[r >> 2][c >> 1][r & 3][c & 1] * rs2; } }
        f32x4 cur[2][4], nxt[2][4];
#pragma unroll
        for (int q = 0; q < 2; ++q)
#pragma unroll
            for (int c = 0; c < 4; ++c) cur[q][c] = *(const f32x4*)(base + (size_t)EPI_ROW(q) * D + col0 + (c >> 1) * HALF + (c & 1) * 4);
#pragma unroll
        for (int k = 0; k < 4; ++k) {
            if (k < 3) {
#pragma unroll
                for (int q = 0; q < 2; ++q)
#pragma unroll
                    for (int c = 0; c < 4; ++c) nxt[q][c] = *(const f32x4*)(base + (size_t)EPI_ROW(2 * k + 2 + q) * D + col0 + (c >> 1) * HALF + (c & 1) * 4);
            }
            asm volatile("" ::: "memory");
#pragma unroll
            for (int q = 0; q < 2; ++q) { const int r = 2 * k + q, ai = r >> 2, m = r & 3; const size_t off = (size_t)EPI_ROW(r) * D + col0; float sr = 0.f;
#pragma unroll
                for (int bj = 0; bj < 2; ++bj) { const f32x4 o0 = cur[q][2 * bj] + acc[ai][bj][m][0], o1 = cur[q][2 * bj + 1] + acc[ai][bj][m][1];
                    *(f32x4*)(out + off + bj * HALF) = o0; *(f32x4*)(out + off + bj * HALF + 4) = o1;
                    u32x4 w; w.x = cvt_pk_bf16(o0[0], o0[1]); w.y = cvt_pk_bf16(o0[2], o0[3]); w.z = cvt_pk_bf16(o1[0], o1[1]); w.w = cvt_pk_bf16(o1[2], o1[3]); *(u32x4*)(hb + off + bj * HALF) = w; sr += ssq4(o0) + ssq4(o1); }
                s[ai][m] = sr; }
            asm volatile("" ::: "memory");
#pragma unroll
            for (int q = 0; q < 2; ++q)
#pragma unroll
                for (int c = 0; c < 4; ++c) cur[q][c] = nxt[q][c];
        }
        tile_ssq<false>(s, u, wr, wc, fr, fq, ssq, ptab);
    }
};
template <bool LAST  > struct EpiPle {
    static constexpr bool PERM = true;
    const bf16_t* pp; float* h; const float* ssq_in; bf16_t* hb; float* ssq_out; LAS float* ptab;
    __device__ __forceinline__ void operator()(f32x4 (&acc)[2][2][4][2], const Unit& u, int wr, int wc, int fr, int fq) const {
        const int col0 = u.pn * BM + wc * 32 + 8 * fq;
        float s[2][4];
        { float rsv[8]; rows_rstd(ssq_in, u.pm * BM + wr * 64 + fr, fr, fq, rsv);
#pragma unroll
            for (int r = 0; r < 8; ++r)
#pragma unroll
                for (int c = 0; c < 4; ++c) acc[r >> 2][c >> 1][r & 3][c & 1] = acc[r >> 2][c >> 1][r & 3][c & 1] * rsv[r]; }
        f32x4 cur[2][4], nxt[2][4]; u32x2 pcur[4], pnxt[4];
#pragma unroll
        for (int q = 0; q < 2; ++q)
#pragma unroll
            for (int c = 0; c < 4; ++c) cur[q][c] = *(const f32x4*)(h + (size_t)EPI_ROW(q) * D + col0 + (c >> 1) * HALF + (c & 1) * 4);
#pragma unroll
        for (int c = 0; c < 4; ++c) pcur[c] = *(const u32x2*)(pp + (size_t)EPI_ROW(0) * D + col0 + (c >> 1) * HALF + (c & 1) * 4);
#pragma unroll
        for (int k = 0; k < 4; ++k) {
            if (k < 3) {
#pragma unroll
                for (int q = 0; q < 2; ++q)
#pragma unroll
                    for (int c = 0; c < 4; ++c) nxt[q][c] = *(const f32x4*)(h + (size_t)EPI_ROW(2 * k + 2 + q) * D + col0 + (c >> 1) * HALF + (c & 1) * 4);
            }
#pragma unroll
            for (int q = 0; q < 2; ++q) { const int r = 2 * k + q, ai = r >> 2, m = r & 3; const size_t off = (size_t)EPI_ROW(r) * D + col0; float sr = 0.f;
                if (r < 7) {
#pragma unroll
                    for (int c = 0; c < 4; ++c) pnxt[c] = *(const u32x2*)(pp + (size_t)EPI_ROW(r + 1) * D + col0 + (c >> 1) * HALF + (c & 1) * 4);
                }
                asm volatile("" ::: "memory");
#pragma unroll
                for (int bj = 0; bj < 2; ++bj) { f32x4 o2[2];
#pragma unroll
                    for (int n = 0; n < 2; ++n) { const f32x4 b = cur[q][2 * bj + n]; const u32x2 qw = pcur[2 * bj + n];
                        const f32x4 pq = (f32x4){bflo(qw.x), bfhi(qw.x), bflo(qw.y), bfhi(qw.y)}; const f32x4 a = acc[ai][bj][m][n];
#pragma unroll
                        for (int j = 0; j < 4; ++j) o2[n][j] = b[j] + pq[j] * sigmoidf_(a[j]); }
                    *(f32x4*)(h + off + bj * HALF) = o2[0]; *(f32x4*)(h + off + bj * HALF + 4) = o2[1];
                    if (!LAST) { u32x4 w; w.x = cvt_pk_bf16(o2[0][0], o2[0][1]); w.y = cvt_pk_bf16(o2[0][2], o2[0][3]); w.z = cvt_pk_bf16(o2[1][0], o2[1][1]); w.w = cvt_pk_bf16(o2[1][2], o2[1][3]);
                        *(u32x4*)(hb + off + bj * HALF) = w; sr += ssq4(o2[0]) + ssq4(o2[1]); } }
                s[ai][m] = sr;
                asm volatile("" ::: "memory");
#pragma unroll
                for (int c = 0; c < 4; ++c) pcur[c] = pnxt[c];
            }
#pragma unroll
            for (int q = 0; q < 2; ++q)
#pragma unroll
                for (int c = 0; c < 4; ++c) cur[q][c] = nxt[q][c];
        }
        if (!LAST) tile_ssq<false>(s, u, wr, wc, fr, fq, ssq_out, ptab);
    }
};
struct EpiLruIn {
    static constexpr bool PERM = false;
    bf16_t* xb; bf16_t* gate; const float* ssq;
    __device__ __forceinline__ void operator()(f32x4 (&acc)[2][2][4][2], const Unit& u, int wr, int wc, int fr, int fq) const {
        const bool isg = u.pn >= 8; const int col0 = (u.pn & 7) * BM + wc * 32 + 4 * fq;
        float rsv[8]; rows_rstd(ssq, u.pm * BM + wr * 64 + fr, fr, fq, rsv);
#pragma unroll
        for (int ai = 0; ai < 2; ++ai)
#pragma unroll
            for (int m = 0; m < 4; ++m) { const int row = u.pm * BM + ai * HALF + wr * 64 + m * 16 + fr; const size_t off = (size_t)row * D + col0;
                const float rs = rsv[ai * 4 + m];
#pragma unroll
                for (int bj = 0; bj < 2; ++bj)
#pragma unroll
                    for (int n = 0; n < 2; ++n) { const f32x4 a = acc[ai][bj][m][n] * rs;
                        if (isg) { u32x2 w; w.x = cvt_pk_bf16(gelu_tanh(a[0]), gelu_tanh(a[1])); w.y = cvt_pk_bf16(gelu_tanh(a[2]), gelu_tanh(a[3])); *(u32x2*)(gate + off + bj * HALF + n * 16) = w; }
                        else { u32x2 w; w.x = cvt_pk_bf16(a[0], a[1]); w.y = cvt_pk_bf16(a[2], a[3]); *(u32x2*)(xb + off + bj * HALF + n * 16) = w; } } }
    }
};
struct EpiLruGate {
    static constexpr bool PERM = false;
    const float* ba; const float* bx; bf16_t* Rbuf; bf16_t* Ibuf;
    __device__ __forceinline__ void operator()(f32x4 (&acc)[2][2][4][2], const Unit& u, int wr, int wc, int fr, int fq) const {
        const int ch0 = u.pn * HALF + wc * 32 + 4 * fq;
#pragma unroll
        for (int ai = 0; ai < 2; ++ai)
#pragma unroll
            for (int m = 0; m < 4; ++m) { const size_t off = (size_t)(u.pm * BM + ai * HALF + wr * 64 + m * 16 + fr) * D + ch0;
#pragma unroll
                for (int n = 0; n < 2; ++n) {
                    const f32x4 ra = acc[ai][0][m][n] + *(const f32x4*)(ba + ch0 + n * 16), rx = acc[ai][1][m][n] + *(const f32x4*)(bx + ch0 + n * 16);
                    u32x2 w0, w1; w0.x = cvt_pk_bf16(sigmoidf_(ra[0]), sigmoidf_(ra[1])); w0.y = cvt_pk_bf16(sigmoidf_(ra[2]), sigmoidf_(ra[3]));
                    w1.x = cvt_pk_bf16(sigmoidf_(rx[0]), sigmoidf_(rx[1])); w1.y = cvt_pk_bf16(sigmoidf_(rx[2]), sigmoidf_(rx[3]));
                    *(u32x2*)(Rbuf + off + n * 16) = w0; *(u32x2*)(Ibuf + off + n * 16) = w1; }
                asm volatile("" ::: "memory"); }
    }
};
struct EpiGlu {
    static constexpr bool PERM = false;
    float* h; bf16_t* hb; float* ssq; LAS float* ptab;
    __device__ __forceinline__ void operator()(f32x4 (&acc)[2][2][4][2], const Unit& u, int wr, int wc, int fr, int fq) const {
        const int ch0 = u.pn * HALF + wc * 32 + 4 * fq;
        float s[2][4];
        f32x4 cur[4][2], nxt[4][2];
#pragma unroll
        for (int q = 0; q < 4; ++q)
#pragma unroll
            for (int n = 0; n < 2; ++n) cur[q][n] = *(const f32x4*)(h + (size_t)EPI_ROW(q) * D + ch0 + n * 16);
#pragma unroll
        for (int k = 0; k < 2; ++k) {
            if (k < 1) {
#pragma unroll
                for (int q = 0; q < 4; ++q)
#pragma unroll
                    for (int n = 0; n < 2; ++n) nxt[q][n] = *(const f32x4*)(h + (size_t)EPI_ROW(4 + q) * D + ch0 + n * 16);
            }
            asm volatile("" ::: "memory");
#pragma unroll
            for (int q = 0; q < 4; ++q) { const int r = 4 * k + q, ai = r >> 2, m = r & 3; const size_t off = (size_t)EPI_ROW(r) * D + ch0; float sr = 0.f;
#pragma unroll
                for (int n = 0; n < 2; ++n) { const f32x4 b = cur[q][n]; const f32x4 v = acc[ai][0][m][n], g = acc[ai][1][m][n]; f32x4 o;
#pragma unroll
                    for (int j = 0; j < 4; ++j) o[j] = b[j] + v[j] * sigmoidf_(g[j]);
                    *(f32x4*)(h + off + n * 16) = o; u32x2 w; w.x = cvt_pk_bf16(o[0], o[1]); w.y = cvt_pk_bf16(o[2], o[3]); *(u32x2*)(hb + off + n * 16) = w; sr += ssq4(o); }
                s[ai][m] = sr; }
            asm volatile("" ::: "memory");
#pragma unroll
            for (int q = 0; q < 4; ++q)
#pragma unroll
                for (int n = 0; n < 2; ++n) cur[q][n] = nxt[q][n];
        }
        tile_ssq<true>(s, u, wr, wc, fr, fq, ssq, ptab);
    }
};
#undef EPI_ROW

template <class Epi>
__device__ __forceinline__ void gemm_phase(LAS unsigned char* lds, const Gemm g, const StaticOrder& S, const Epi& E) {
    const int tid = launder(threadIdx.x), wid = __builtin_amdgcn_readfirstlane(tid >> 6), lane = tid & 63, wr = wid >> 2, wc = wid & 3, fr = lane & 15, fq = lane >> 4;
    const int K = g.K, nt = K / BK;
    unsigned voffA[2], voffB[2];
#pragma unroll
    for (int i = 0; i < 2; ++i) { int R, C; stage_rc(tid * 16 + i * 8192, R, C); const int Rb = Epi::PERM ? ((R & ~31) + perm32(R & 31)) : R;
        voffA[i] = (unsigned)(R * g.lda + C) * 2u; voffB[i] = (unsigned)(Rb * g.ldb + C) * 2u; }
    const size_t kstep = (size_t)(BK * 2);
    const size_t hstepA = (size_t)HALF * g.lda * 2, hstepB = (size_t)HALF * g.ldb * 2;
    const size_t tstepA = 2 * hstepA, tstepB = 2 * hstepB;
    const unsigned ldsw = (unsigned)wid * 1024u;
    const int aoff = lds_byte(wr * 64 + fr, fq * 8), boff = lds_byte(wc * 32 + fr, fq * 8);
#define PG8_UA(u) ((const char*)g.A + (size_t)(u).pm * tstepA + (size_t)(((u).pn >> g.acol_shift) * g.acol_mul) * 2)
#define PG8_UB(u) ((const char*)g.Bt + (size_t)(u).pn * tstepB)
#define PG8_SA(b, h) (((b) * 2 + (h)) * HTB)
#define PG8_SB(b, h) ((4 + (b) * 2 + (h)) * HTB)
#define PG8_STAGE(bufoff, gbase, voff) do { _Pragma("unroll") for (int _i = 0; _i < 2; ++_i) \
        __builtin_amdgcn_global_load_lds((const unsigned*)((const char*)(gbase) + (voff)[_i]), (LAS unsigned*)(lds + (bufoff) + ldsw + _i * 8192), 16, 0, 0); } while (0)
#define PG8_LDA(dst, b, h) do { _Pragma("unroll") for (int m = 0; m < 4; ++m) _Pragma("unroll") for (int k = 0; k < 2; ++k) dst[m][k] = *(const LAS bf16x8*)(lds + PG8_SA(b, h) + aoff + m * 2048 + k * 1024); } while (0)
#define PG8_LDB(dst, b, h) do { _Pragma("unroll") for (int n = 0; n < 2; ++n) _Pragma("unroll") for (int k = 0; k < 2; ++k) dst[n][k] = *(const LAS bf16x8*)(lds + PG8_SB(b, h) + boff + n * 2048 + k * 1024); } while (0)
#define PG8_MMA(ai, bj, At, Bt) do { __builtin_amdgcn_s_setprio(1); _Pragma("unroll") for (int m = 0; m < 4; ++m) _Pragma("unroll") for (int n = 0; n < 2; ++n) _Pragma("unroll") for (int k = 0; k < 2; ++k) \
        acc[ai][bj][m][n] = __builtin_amdgcn_mfma_f32_16x16x32_bf16(Bt[n][k], At[m][k], acc[ai][bj][m][n], 0, 0, 0); __builtin_amdgcn_s_setprio(0); } while (0)
#define PG8_WAIT_V(n) asm volatile("s_waitcnt vmcnt(" #n ")" ::: "memory")
#define PG8_WAIT_L(n) asm volatile("s_waitcnt lgkmcnt(" #n ")" ::: "memory")
#define PG8_BAR __builtin_amdgcn_s_barrier()
#define PG8_SCHED __builtin_amdgcn_sched_barrier(0)
    Unit cur, nxt; int ui = 0;
    if (!S.next(0, cur)) return;
    f32x4 acc[2][2][4][2];
#pragma unroll
    for (int a = 0; a < 2; ++a)
#pragma unroll
        for (int b = 0; b < 2; ++b)
#pragma unroll
            for (int m = 0; m < 4; ++m)
#pragma unroll
                for (int n = 0; n < 2; ++n) acc[a][b][m][n] = (f32x4){0.f, 0.f, 0.f, 0.f};
    bf16x8 At[4][2], B0[2][2], B1[2][2];
    const char* cA = PG8_UA(cur); const char* cB = PG8_UB(cur);
    PG8_STAGE(PG8_SB(0, 0), cB, voffB); PG8_STAGE(PG8_SB(0, 1), cB + hstepB, voffB); PG8_STAGE(PG8_SA(0, 0), cA, voffA); PG8_STAGE(PG8_SA(0, 1), cA + hstepA, voffA);
    if (wr == 1) PG8_BAR;
    PG8_WAIT_V(2); PG8_BAR;
    PG8_STAGE(PG8_SB(1, 0), cB + kstep, voffB); PG8_STAGE(PG8_SA(1, 0), cA + kstep, voffA); PG8_STAGE(PG8_SB(1, 1), cB + hstepB + kstep, voffB);
    PG8_WAIT_V(6); PG8_BAR;
    for (;;) {
        const bool has_next = S.next(ui + 1, nxt);
        const char* nA = has_next ? PG8_UA(nxt) : cA; const char* nB = has_next ? PG8_UB(nxt) : cB;
        for (int t = 0; t < nt; t += 2) {
            const bool last = (t == nt - 2);
            const char* a1 = cA + (size_t)(t + 1) * kstep;
            const char* a2 = last ? nA : cA + (size_t)(t + 2) * kstep; const char* b2 = last ? nB : cB + (size_t)(t + 2) * kstep;
            const char* a3 = a2 + kstep; const char* b3 = b2 + kstep;
            PG8_LDB(B0, 0, 0); PG8_LDB(B1, 0, 1); PG8_SCHED; PG8_LDA(At, 0, 0); PG8_STAGE(PG8_SA(1, 1), a1 + hstepA, voffA);
            PG8_WAIT_V(8); PG8_WAIT_L(0); PG8_BAR; PG8_MMA(0, 0, At, B0); PG8_MMA(0, 1, At, B1); PG8_BAR; PG8_SCHED;
            PG8_LDA(At, 0, 1); PG8_STAGE(PG8_SB(0, 0), b2, voffB); PG8_STAGE(PG8_SB(0, 1), b2 + hstepB, voffB); PG8_STAGE(PG8_SA(0, 0), a2, voffA);
            PG8_WAIT_V(8); PG8_WAIT_L(0); PG8_BAR; PG8_MMA(1, 0, At, B0); PG8_MMA(1, 1, At, B1); PG8_BAR; PG8_SCHED;
            PG8_LDB(B0, 1, 0); PG8_LDB(B1, 1, 1); PG8_SCHED; PG8_LDA(At, 1, 0); PG8_STAGE(PG8_SA(0, 1), a2 + hstepA, voffA);
            PG8_WAIT_V(8); PG8_WAIT_L(0); PG8_BAR; PG8_MMA(0, 0, At, B0); PG8_MMA(0, 1, At, B1); PG8_BAR; PG8_SCHED;
            PG8_LDA(At, 1, 1); PG8_STAGE(PG8_SB(1, 0), b3, voffB); PG8_STAGE(PG8_SB(1, 1), b3 + hstepB, voffB); PG8_STAGE(PG8_SA(1, 0), a3, voffA);
            PG8_WAIT_V(8); PG8_WAIT_L(0); PG8_BAR; PG8_MMA(1, 0, At, B0); PG8_MMA(1, 1, At, B1); PG8_BAR; PG8_SCHED;
        }
        if (wr == 0) PG8_BAR;
        { const int l2 = launder(threadIdx.x) & 63; E(acc, cur, wr, wc, l2 & 15, l2 >> 4); }
        if (!has_next) break;
#pragma unroll
        for (int a = 0; a < 2; ++a)
#pragma unroll
            for (int b = 0; b < 2; ++b)
#pragma unroll
                for (int m = 0; m < 4; ++m)
#pragma unroll
                    for (int n = 0; n < 2; ++n) acc[a][b][m][n] = (f32x4){0.f, 0.f, 0.f, 0.f};
        cur = nxt; cA = nA; cB = nB; ++ui;
        if (wr == 1) PG8_BAR;
    }
    PG8_WAIT_V(0);
    PG8_BAR;
#undef PG8_UA
#undef PG8_UB
#undef PG8_SA
#undef PG8_SB
#undef PG8_STAGE
#undef PG8_LDA
#undef PG8_LDB
#undef PG8_MMA
#undef PG8_WAIT_V
#undef PG8_WAIT_L
#undef PG8_BAR
#undef PG8_SCHED
}
}

constexpr size_t MiB = 1u << 20;
constexpr size_t WS_CTL = 0, CTL_ZERO_BYTES = 64 * 1024;
constexpr size_t SZ_UP = (size_t)D * DFF * 2, SZ_DD = (size_t)D * D * 2, SZ_PLE = (size_t)PLE * D * 2;
constexpr size_t SZ_LAYER_COMMON = 2 * SZ_UP + SZ_DD + SZ_PLE;
constexpr size_t WS_W = 1 * MiB;
constexpr size_t WOFF_UP = 0, WOFF_DOWN = SZ_UP, WOFF_PG = 2 * SZ_UP, WOFF_PLE = 2 * SZ_UP + SZ_DD;
constexpr size_t WS_WMIX = WS_W + 4 * SZ_LAYER_COMMON;
constexpr size_t SZ_QKV = (size_t)D * NQKV * 2;
constexpr size_t WM_A0_QKV = 0, WM_A0_O = SZ_QKV;
constexpr size_t WM_B_IN = WM_A0_O + SZ_DD, WM_B_G = WM_B_IN + 2 * SZ_DD, WM_B_O = WM_B_G + (size_t)4096 * 256 * 2;
constexpr size_t WM_C_IN = WM_B_O + SZ_DD, WM_C_GLU = WM_C_IN + SZ_DD;
constexpr size_t WM_A3_QKV = WM_C_GLU + 2 * SZ_DD, WM_A3_O = WM_A3_QKV + SZ_QKV;
constexpr size_t WM_END = WM_A3_O + SZ_DD;
constexpr size_t WS_ACT = ((WS_WMIX + WM_END + MiB - 1) / MiB) * MiB;
constexpr size_t WS_HN = WS_ACT;
constexpr size_t WS_PP = WS_HN + 32 * MiB;
constexpr size_t WS_PBF = WS_PP + 64 * MiB;
constexpr size_t WS_BIG = WS_PBF + 16 * MiB;
constexpr size_t WS_HB1 = WS_BIG + 192 * MiB;
constexpr size_t WS_SSQ0 = WS_HB1 + 32 * MiB, WS_SSQ1 = WS_SSQ0 + 1 * MiB;
constexpr size_t WS_END = WS_SSQ1 + 1 * MiB;
constexpr size_t BG_QKV = 0, BG_AO = 64 * MiB;
constexpr size_t BG_XB = 0, BG_BB = 64 * MiB, BG_GATE = 128 * MiB, BG_XC = 160 * MiB, BG_PE = 96 * MiB  ;
constexpr size_t BG_U = 0, BG_G = 64 * MiB, BG_ES = 128 * MiB;
constexpr size_t WS_SCAN = WS_PP;

constexpr int LDS_BYTES = 147456;

#if USE_XCD_BARRIER
#define XB_TMO      128
#define XB_XCNT(j)  (256  + 64 * (j))
#define XB_XSUB(j)  (1280 + 64 * (j))
#define XB_XGEN(j)  (2304 + 64 * (j))
#define XB_TOP      3328
#define XB_TOPGEN   3392
#define XCD_BAR_WORDS 3456
#define XB_SPIN_CAP (1u << 22)
__device__ __forceinline__ unsigned xb_ld(unsigned* p)              { return __hip_atomic_load(p, __ATOMIC_RELAXED, __HIP_MEMORY_SCOPE_AGENT); }
__device__ __forceinline__ unsigned xb_add(unsigned* p, unsigned v) { return __hip_atomic_fetch_add(p, v, __ATOMIC_RELAXED, __HIP_MEMORY_SCOPE_AGENT); }
__device__ __forceinline__ unsigned xb_xcc_id() { return (unsigned)__builtin_amdgcn_s_getreg((3 << 11) | 20) & 0xFu; }
#define XB_SPIN(cond, bar) do { unsigned _sp = 0; while (cond) { __builtin_amdgcn_s_sleep(1); \
    if ((++_sp & 255u) == 0u) { if (xb_ld(&(bar)[XB_TMO])) break; if (_sp > XB_SPIN_CAP) { atomicAdd(&(bar)[XB_TMO], 1u); break; } } } } while (0)
struct XcdBarrier { unsigned* bar; unsigned x; volatile LAS unsigned* st; };
__device__ __forceinline__ XcdBarrier xcd_barrier_post(unsigned* bar, volatile LAS unsigned* st) {
    XcdBarrier b; b.bar = bar; b.x = xb_xcc_id(); b.st = st;
    if (threadIdx.x == 0) (void)xb_add(&bar[XB_XCNT(b.x)], 1u);
    return b;
}
__device__ __forceinline__ void xcd_barrier_complete(unsigned* bar, unsigned x, unsigned& nloc, unsigned& nx) {
    const unsigned G = gridDim.x * gridDim.y * gridDim.z;
    unsigned sum, cnt, mine, sp = 0u;
    for (;;) {
        sum = 0u; cnt = 0u; mine = 0u;
#pragma unroll
        for (unsigned j = 0; j < 16; ++j) { const unsigned c = xb_ld(&bar[XB_XCNT(j)]); sum += c; cnt += (c > 0u) ? 1u : 0u; mine = (j == x) ? c : mine; }
        if (sum == G) break;
        __builtin_amdgcn_s_sleep(1);
        if ((++sp & 255u) == 0u) { if (xb_ld(&bar[XB_TMO])) break; if (sp > XB_SPIN_CAP) { atomicAdd(&bar[XB_TMO], 1u); break; } }
    }
    nloc = mine > 0u ? mine : 1u; nx = cnt > 0u ? cnt : 1u;
}
__device__ __forceinline__ void xcd_barrier(const XcdBarrier& b) {
    asm volatile("s_waitcnt vmcnt(0)" ::: "memory");
    __syncthreads();
    if (threadIdx.x == 0) {
        unsigned* bar = b.bar;
        __builtin_amdgcn_s_waitcnt(0);
        unsigned nloc = b.st[0], nx = b.st[1];
        if (nloc == 0u) { xcd_barrier_complete(bar, b.x, nloc, nx); b.st[0] = nloc; b.st[1] = nx; }
        const unsigned old = xb_add(&bar[XB_XSUB(b.x)], 1u);
        const unsigned gen = old / nloc;
        if (old + 1u == (gen + 1u) * nloc) {
            __builtin_amdgcn_fence(__ATOMIC_RELEASE, "agent");
            asm volatile("s_waitcnt vmcnt(0)" ::: "memory");
            const unsigned og = xb_add(&bar[XB_TOP], 1u);
            const unsigned tg = og / nx;
            if (og + 1u == (tg + 1u) * nx) xb_add(&bar[XB_TOPGEN], 1u);
            else XB_SPIN(xb_ld(&bar[XB_TOPGEN]) == tg, bar);
            __builtin_amdgcn_fence(__ATOMIC_ACQUIRE, "agent");
            xb_add(&bar[XB_XGEN(b.x)], 1u);
            asm volatile("s_waitcnt vmcnt(0)" ::: "memory");
        } else {
            XB_SPIN(xb_ld(&bar[XB_XGEN(b.x)]) == gen, bar);
            __builtin_amdgcn_fence(__ATOMIC_ACQUIRE, "agent");
            asm volatile("s_waitcnt vmcnt(0)" ::: "memory");
        }
    }
    __syncthreads();
}
#endif

__device__ __forceinline__ int rowmap(int mode, int ch) { return mode == 0 ? ch : (((ch >> 7) << 8) + (ch & 127) + (mode == 2 ? 128 : 0)); }
struct TrRegs { f32x4 v[16]; };
__device__ __forceinline__ void tr_load(TrRegs& R, const float* W, int ldw, int k0, int n0, int lane, const float* gain) {
    const int rr = lane >> 4, q4 = (lane & 15) * 4;
#pragma unroll
    for (int it = 0; it < 16; ++it) { const int kk = it * 4 + rr; R.v[it] = __builtin_nontemporal_load((const f32x4*)(W + (size_t)(k0 + kk) * ldw + n0 + q4));     if (gain) R.v[it] = R.v[it] * gain[k0 + kk]; }
}
__device__ __forceinline__ void tr_store(const TrRegs& R, bf16_t* WT, int ldt, int k0, int mode, int ch0, LAS float* scr, int lane) {
    const int rr = lane >> 4, q4 = (lane & 15) * 4;
#pragma unroll
    for (int it = 0; it < 16; ++it) { const int kk = it * 4 + rr; LAS float* sp = scr + kk * 65 + q4; sp[0] = R.v[it][0]; sp[1] = R.v[it][1]; sp[2] = R.v[it][2]; sp[3] = R.v[it][3]; }
    LDS_WAIT(); __builtin_amdgcn_wave_barrier();
    const int c = lane & 7;
#pragma unroll
    for (int it = 0; it < 8; ++it) { const int n = it * 8 + (lane >> 3); const LAS float* sp = scr + (8 * c) * 65 + n;
        u32x4 o; o.x = cvt_pk_bf16(sp[0 * 65], sp[1 * 65]); o.y = cvt_pk_bf16(sp[2 * 65], sp[3 * 65]); o.z = cvt_pk_bf16(sp[4 * 65], sp[5 * 65]); o.w = cvt_pk_bf16(sp[6 * 65], sp[7 * 65]);
        __builtin_nontemporal_store(o, (u32x4*)(WT + (size_t)rowmap(mode, ch0 + n) * ldt + k0 + 8 * c)); }
    LDS_WAIT(); __builtin_amdgcn_wave_barrier();
}
__device__ __forceinline__ void tr_tile(const float* W, int ldw, bf16_t* WT, int ldt, int k0, int n0, int mode, int ch0, LAS float* scr, int lane, const float* gain = nullptr) {
    TrRegs R; tr_load(R, W, ldw, k0, n0, lane, gain); tr_store(R, WT, ldt, k0, mode, ch0, scr, lane);
}
__device__ __forceinline__ void tr_matrix(const float* W, int K, int N, bf16_t* WT, int mode, int ch_base, LAS float* scr, int lane, int gw, int ngw, int& base, const float* gain = nullptr) {
    const int nb = N / 64, tiles = (K / 64) * nb;
    int start = gw - (base % ngw); if (start < 0) start += ngw;
    base += tiles;
    if (start >= tiles) return;
    TrRegs cur; tr_load(cur, W, N, (start / nb) * 64, (start % nb) * 64, lane, gain);
    for (int it = start; it < tiles; it += ngw) {
        const int kb = it / nb, n0 = (it % nb) * 64; const int itn = it + ngw;
        TrRegs nxt;
        if (itn < tiles) tr_load(nxt, W, N, (itn / nb) * 64, (itn % nb) * 64, lane, gain);
        tr_store(cur, WT, K, kb * 64, mode, ch_base + n0, scr, lane);
        if (itn < tiles) cur = nxt;
    }
}

__device__ __forceinline__ void prep_phase(const float* h, bf16_t* hb, float* ssq, int bid, int G) {
    const int tid = launder(threadIdx.x), lane = tid & 63, gw = bid * NWAVES + __builtin_amdgcn_readfirstlane(tid >> 6), ngw = G * NWAVES;
    for (int r = gw; r < T; r += ngw) {
        const f32x4* xr = (const f32x4*)(h + (size_t)r * D) + lane;
        f32x4 v[8]; float s = 0.f;
#pragma unroll
        for (int j = 0; j < 8; ++j) { v[j] = __builtin_nontemporal_load(xr + 64 * j); s += (v[j][0] * v[j][0] + v[j][1] * v[j][1]) + (v[j][2] * v[j][2] + v[j][3] * v[j][3]); }
        s = wave_sum(s, lane);
        u32x2* o = (u32x2*)(hb + (size_t)r * D) + lane;
#pragma unroll
        for (int j = 0; j < 8; ++j) { u32x2 w; w.x = cvt_pk_bf16(v[j][0], v[j][1]); w.y = cvt_pk_bf16(v[j][2], v[j][3]); o[64 * j] = w; }
        if (lane < 16) ssq[(size_t)r * 16 + lane] = lane == 0 ? s : 0.f;
    }
}

constexpr int KS_STRIDE = 144;
constexpr int VT_STRIDE = 528;
constexpr int ATT_KS = 0, ATT_VT = 256 * KS_STRIDE, ATT_KP = ATT_VT + 64 * VT_STRIDE, ATT_END = ATT_KP + 1024;
__device__ __forceinline__ void attn_phase(LAS unsigned char* lds, const bf16_t* QKV, const int* positions, const float* qn, const float* kn, const float* sinks, bf16_t* AO, int G, int bid) {
    const int tid = launder(threadIdx.x), lane = tid & 63, wave = __builtin_amdgcn_readfirstlane(tid >> 6);
    const int fr = lane & 15, fq = lane >> 4;
    for (int unit = bid; unit < (T / 128) * 4; unit += G) {
        const int nb = unit >> 2, hk = unit & 3;
        {
            const int kk = tid >> 1, half = tid & 1; const int tok = (nb - 1) * 128 + kk;
            u32x4 kraw[4], vraw[4];
            if (tok >= 0) {
                const u32x4* kp = (const u32x4*)(QKV + (size_t)tok * NQKV + 2048 + hk * 64 + half * 32);
                const u32x4* vp = (const u32x4*)(QKV + (size_t)tok * NQKV + 2304 + hk * 64 + half * 32);
#pragma unroll
                for (int i = 0; i < 4; ++i) { kraw[i] = kp[i]; vraw[i] = vp[i]; }
            } else {
#pragma unroll
                for (int i = 0; i < 4; ++i) { kraw[i] = (u32x4){0u, 0u, 0u, 0u}; vraw[i] = (u32x4){0u, 0u, 0u, 0u}; }
            }
            float ss = 0.f;
#pragma unroll
            for (int i = 0; i < 4; ++i)
#pragma unroll
                for (int j = 0; j < 4; ++j) { const float a = bflo(kraw[i][j]), b = bfhi(kraw[i][j]); ss += a * a + b * b; }
            ss += shx(ss, 1, lane);
            const float rstd = rsqrtf(ss * (1.0f / 64.0f) + EPS);
            LAS unsigned char* krow = lds + ATT_KS + kk * KS_STRIDE + half * 64;
#pragma unroll
            for (int i = 0; i < 4; ++i) { u32x4 w;
#pragma unroll
                for (int j = 0; j < 4; ++j) { const int d = half * 32 + i * 8 + j * 2; w[j] = cvt_pk_bf16(bflo(kraw[i][j]) * rstd * kn[d], bfhi(kraw[i][j]) * rstd * kn[d + 1]); }
                *(LAS u32x4*)(krow + i * 16) = w; }
#pragma unroll
            for (int i = 0; i < 4; ++i)
#pragma unroll
                for (int j = 0; j < 4; ++j) { const int d = half * 32 + i * 8 + j * 2;
                    *(LAS unsigned short*)(lds + ATT_VT + d * VT_STRIDE + kk * 2) = (unsigned short)(vraw[i][j] & 0xffffu);
                    *(LAS unsigned short*)(lds + ATT_VT + (d + 1) * VT_STRIDE + kk * 2) = (unsigned short)(vraw[i][j] >> 16); }
            if (half == 0) ((LAS int*)(lds + ATT_KP))[kk] = tok >= 0 ? positions[tok] : PAD_POS;
        }
        __syncthreads();
        const int h = hk * 8 + wave;
        const float slope = exp2f(-0.25f * (float)(h + 1));
        const float sink = sinks[h];
        u32x4 q0n = *(const u32x4*)(QKV + (size_t)(nb * 128 + fr) * NQKV + h * 64 + fq * 8);
        u32x4 q1n = *(const u32x4*)(QKV + (size_t)(nb * 128 + fr) * NQKV + h * 64 + 32 + fq * 8);
        int qposn = positions[nb * 128 + fr];
        for (int qt = 0; qt < 8; ++qt) {
            const int tq = nb * 128 + qt * 16 + fr;
            const int qpos = qposn;
            const u32x4 q0 = q0n, q1 = q1n;
            { const int tqn = nb * 128 + (qt < 7 ? qt + 1 : qt) * 16 + fr;
              q0n = *(const u32x4*)(QKV + (size_t)tqn * NQKV + h * 64 + fq * 8); q1n = *(const u32x4*)(QKV + (size_t)tqn * NQKV + h * 64 + 32 + fq * 8); qposn = positions[tqn]; }
            bf16x8 qf[2];
            {
                float ss = 0.f;
#pragma unroll
                for (int j = 0; j < 4; ++j) { const float a = bflo(q0[j]), b = bfhi(q0[j]), c = bflo(q1[j]), d = bfhi(q1[j]); ss += (a * a + b * b) + (c * c + d * d); }
                ss += shx(ss, 16, lane); ss += shx(ss, 32, lane);
                const float rs = rsqrtf(ss * (1.0f / 64.0f) + EPS) * 0.125f;
                u32x4 w0, w1;
#pragma unroll
                for (int j = 0; j < 4; ++j) { const int d = fq * 8 + j * 2;
                    w0[j] = cvt_pk_bf16(bflo(q0[j]) * rs * qn[d], bfhi(q0[j]) * rs * qn[d + 1]);
                    w1[j] = cvt_pk_bf16(bflo(q1[j]) * rs * qn[32 + d], bfhi(q1[j]) * rs * qn[32 + d + 1]); }
                qf[0] = __builtin_bit_cast(bf16x8, w0); qf[1] = __builtin_bit_cast(bf16x8, w1);
            }
            f32x4 s[16];
            float mx = sink;
            unsigned live = 0u;
#pragma unroll
            for (int kf = 0; kf < 16; ++kf) {
                const LAS int* kp = (const LAS int*)(lds + ATT_KP) + kf * 16 + fq * 4;
                int dist[4]; bool anyv = false;
#pragma unroll
                for (int i = 0; i < 4; ++i) { dist[i] = qpos - kp[i]; anyv = anyv || ((unsigned)dist[i] < 128u); }
                if (__builtin_amdgcn_ballot_w64(anyv) == 0ull) { s[kf] = (f32x4){0.f, 0.f, 0.f, 0.f}; continue; }
                live |= 1u << kf;
                f32x4 a = (f32x4){0.f, 0.f, 0.f, 0.f};
#pragma unroll
                for (int ks = 0; ks < 2; ++ks) { const bf16x8 kfrag = *(const LAS bf16x8*)(lds + ATT_KS + (kf * 16 + fr) * KS_STRIDE + ks * 64 + fq * 16);
                    a = __builtin_amdgcn_mfma_f32_16x16x32_bf16(kfrag, qf[ks], a, 0, 0, 0); }
#pragma unroll
                for (int i = 0; i < 4; ++i) { const bool valid = (unsigned)dist[i] < 128u;
                    const float v = valid ? a[i] - slope * (float)dist[i] : -INFINITY; a[i] = v; mx = fmaxf(mx, v); }
                s[kf] = a;
            }
            mx = fmaxf(mx, shx(mx, 16, lane)); mx = fmaxf(mx, shx(mx, 32, lane));
            float sum = 0.f;
#pragma unroll
            for (int kf = 0; kf < 16; ++kf) {
                if (!((live >> kf) & 1u)) continue;
#pragma unroll
                for (int i = 0; i < 4; ++i) { const float p = __expf(s[kf][i] - mx); s[kf][i] = p; sum += p; }
            }
            sum += shx(sum, 16, lane); sum += shx(sum, 32, lane);
            const float inv = 1.0f / (sum + __expf(sink - mx));
            f32x4 o[4];
#pragma unroll
            for (int df = 0; df < 4; ++df) o[df] = (f32x4){0.f, 0.f, 0.f, 0.f};
#pragma unroll
            for (int w2 = 0; w2 < 8; ++w2) {
                if (!((live >> (2 * w2)) & 3u)) continue;
                u32x4 pw; pw.x = cvt_pk_bf16(s[2 * w2][0], s[2 * w2][1]); pw.y = cvt_pk_bf16(s[2 * w2][2], s[2 * w2][3]); pw.z = cvt_pk_bf16(s[2 * w2 + 1][0], s[2 * w2 + 1][1]); pw.w = cvt_pk_bf16(s[2 * w2 + 1][2], s[2 * w2 + 1][3]);
                const bf16x8 pf = __builtin_bit_cast(bf16x8, pw);
#pragma unroll
                for (int df = 0; df < 4; ++df) {
                    const LAS unsigned char* vr = lds + ATT_VT + (df * 16 + fr) * VT_STRIDE + (w2 * 32 + fq * 4) * 2;
                    const u32x2 v0 = *(const LAS u32x2*)vr, v1 = *(const LAS u32x2*)(vr + 32);
                    u32x4 vw; vw.x = v0.x; vw.y = v0.y; vw.z = v1.x; vw.w = v1.y;
                    o[df] = __builtin_amdgcn_mfma_f32_16x16x32_bf16(__builtin_bit_cast(bf16x8, vw), pf, o[df], 0, 0, 0);
                }
            }
#pragma unroll
            for (int df = 0; df < 4; ++df) { u32x2 w; w.x = cvt_pk_bf16(o[df][0] * inv, o[df][1] * inv); w.y = cvt_pk_bf16(o[df][2] * inv, o[df][3] * inv);
                *(u32x2*)(AO + (size_t)tq * D + h * 64 + df * 16 + fq * 4) = w; }
        }
        __syncthreads();
    }
}

__device__ __forceinline__ f32x4 ld_bf4(const bf16_t* p) { const u32x2 w = *(const u32x2*)p; return (f32x4){bflo(w.x), bfhi(w.x), bflo(w.y), bfhi(w.y)}; }
__device__ __forceinline__ f32x4 bf4_f32(const u32x2 w) { return (f32x4){bflo(w.x), bfhi(w.x), bflo(w.y), bfhi(w.y)}; }
constexpr int CONV_R = 32;
__device__ __forceinline__ void conv_phase(const bf16_t* XB, const float* cw, const float* cb, bf16_t* XC, int bid, int G) {
    const int gtid = bid * NTHR + launder(threadIdx.x), nthreads = G * NTHR;
    for (int item = gtid; item < (T / CONV_R) * 512; item += nthreads) {
        const int c = (item & 511) * 4, t0 = (item >> 9) * CONV_R;
        u32x2 raw[CONV_R + 3];
#pragma unroll
        for (int i = 0; i < CONV_R + 3; ++i) { const int t = t0 - 3 + i; raw[i] = t >= 0 ? *(const u32x2*)(XB + (size_t)t * D + c) : (u32x2){0u, 0u}; }
        const f32x4 w0 = *(const f32x4*)(cw + c), w1 = *(const f32x4*)(cw + D + c), w2 = *(const f32x4*)(cw + 2 * D + c), w3 = *(const f32x4*)(cw + 3 * D + c), bb = *(const f32x4*)(cb + c);
        f32x4 xm3 = bf4_f32(raw[0]), xm2 = bf4_f32(raw[1]), xm1 = bf4_f32(raw[2]);
#pragma unroll
        for (int i = 0; i < CONV_R; ++i) {
            const f32x4 x = bf4_f32(raw[i + 3]);
            const f32x4 y = bb + w0 * xm3 + w1 * xm2 + w2 * xm1 + w3 * x;
            u32x2 w; w.x = cvt_pk_bf16(y[0], y[1]); w.y = cvt_pk_bf16(y[2], y[3]);
            *(u32x2*)(XC + (size_t)(t0 + i) * D + c) = w;
            xm3 = xm2; xm2 = xm1; xm1 = x;
        }
    }
}
constexpr int LRU_CH = 128, LRU_NC = T / LRU_CH;
__device__ __forceinline__ float lru_sp(float lam) { const float x = -lam; return -8.0f * ((x > 0.f ? x : 0.f) + log1pf(__expf(-fabsf(x)))); }
__device__ __forceinline__ void lru_ab(float r, float ii, float xcv, float sp, float& a, float& b) {
    const float la = r * sp;
    a = __expf(la);
    const float em = la > -0.01f ? -2.0f * la * (1.0f + la * (1.0f + 0.6666667f * la)) : 1.0f - a * a;
    b = __builtin_amdgcn_sqrtf(fmaxf(em, 0.f)) * ii * xcv;
}
constexpr int LB = 16;
__device__ __forceinline__ void lru_scan1(const bf16_t* Ab, const bf16_t* Bb, const bf16_t* XC, const float* lam, float* PE, int bid, int G) {
    const int gtid = bid * NTHR + launder(threadIdx.x), nthreads = G * NTHR;
    for (int item = gtid; item < LRU_NC * D; item += nthreads) {
        const int ch = item & (D - 1), c = item >> 11;
        const float sp = lru_sp(lam[ch]);
        const bf16_t* ap = Ab + (size_t)c * LRU_CH * D + ch; const bf16_t* bp = Bb + (size_t)c * LRU_CH * D + ch; const bf16_t* xp = XC + (size_t)c * LRU_CH * D + ch;
        float P = 1.f, hst = 0.f;
        float ra[LB], rx[LB], xv[LB];
#pragma unroll
        for (int i = 0; i < LB; ++i) { ra[i] = bf2f(ap[(size_t)i * D]); rx[i] = bf2f(bp[(size_t)i * D]); xv[i] = bf2f(xp[(size_t)i * D]); }
        for (int t = 0; t < LRU_CH; t += LB) {
            float ra2[LB], rx2[LB], xv2[LB];
            const int tn = (t + LB < LRU_CH) ? t + LB : t;
#pragma unroll
            for (int i = 0; i < LB; ++i) { ra2[i] = bf2f(ap[(size_t)(tn + i) * D]); rx2[i] = bf2f(bp[(size_t)(tn + i) * D]); xv2[i] = bf2f(xp[(size_t)(tn + i) * D]); }
#pragma unroll
            for (int i = 0; i < LB; ++i) { float a, b; lru_ab(ra[i], rx[i], xv[i], sp, a, b); hst = a * hst + b; P *= a; }
#pragma unroll
            for (int i = 0; i < LB; ++i) { ra[i] = ra2[i]; rx[i] = rx2[i]; xv[i] = xv2[i]; }
        }
        PE[(size_t)c * D + ch] = P; PE[(size_t)(LRU_NC + c) * D + ch] = hst;
    }
}
__device__ __forceinline__ void lru_scan2(const bf16_t* Ab, const bf16_t* Bb, const bf16_t* XC, const float* lam, const float* PE, const bf16_t* gate, bf16_t* Y, int bid, int G) {
    const int gtid = bid * NTHR + launder(threadIdx.x), nthreads = G * NTHR;
    for (int item = gtid; item < LRU_NC * D; item += nthreads) {
        const int ch = item & (D - 1), c = item >> 11;
        const float sp = lru_sp(lam[ch]);
        const size_t o0 = (size_t)c * LRU_CH * D + ch;
        const bf16_t* ap = Ab + o0; const bf16_t* bp = Bb + o0; const bf16_t* xp = XC + o0; const bf16_t* gp = gate + o0; bf16_t* yp = Y + o0;
        float ra[LB], rx[LB], xv[LB], g[LB];
#pragma unroll
        for (int i = 0; i < LB; ++i) { ra[i] = bf2f(ap[(size_t)i * D]); rx[i] = bf2f(bp[(size_t)i * D]); xv[i] = bf2f(xp[(size_t)i * D]); g[i] = bf2f(gp[(size_t)i * D]); }
        float hst = 0.f;
        {
            int cc = 0;
            for (; cc + 8 <= c; cc += 8) { float p[8], e[8];
#pragma unroll
                for (int i = 0; i < 8; ++i) { p[i] = PE[(size_t)(cc + i) * D + ch]; e[i] = PE[(size_t)(LRU_NC + cc + i) * D + ch]; }
#pragma unroll
                for (int i = 0; i < 8; ++i) hst = p[i] * hst + e[i]; }
            for (; cc < c; ++cc) hst = PE[(size_t)cc * D + ch] * hst + PE[(size_t)(LRU_NC + cc) * D + ch];
        }
        for (int t = 0; t < LRU_CH; t += LB) {
            float ra2[LB], rx2[LB], xv2[LB], g2[LB];
            const int tn = (t + LB < LRU_CH) ? t + LB : t;
#pragma unroll
            for (int i = 0; i < LB; ++i) { ra2[i] = bf2f(ap[(size_t)(tn + i) * D]); rx2[i] = bf2f(bp[(size_t)(tn + i) * D]); xv2[i] = bf2f(xp[(size_t)(tn + i) * D]); g2[i] = bf2f(gp[(size_t)(tn + i) * D]); }
#pragma unroll
            for (int i = 0; i < LB; ++i) { float a, b; lru_ab(ra[i], rx[i], xv[i], sp, a, b); hst = a * hst + b; const unsigned w = cvt_pk_bf16(hst * g[i], 0.f); yp[(size_t)(t + i) * D] = (bf16_t)(w & 0xffffu); }
#pragma unroll
            for (int i = 0; i < LB; ++i) { ra[i] = ra2[i]; rx[i] = rx2[i]; xv[i] = xv2[i]; g[i] = g2[i]; }
        }
    }
}

constexpr int S5_L = 256, S5_NC = T / S5_L;
constexpr int S5_BU_STRIDE = 528;
constexpr int S5_SB_STRIDE = 272;
constexpr int S5_OFF_SB = 16 * S5_BU_STRIDE, S5_OFF_U = S5_OFF_SB + 16 * S5_SB_STRIDE, S5_OFF_Z = S5_OFF_U + 1024, S5_WAVE_LDS = S5_OFF_Z + 512;
struct S5Params { const float *a_re, *a_im, *log_dt, *b_re, *b_im, *c_re, *c_im, *d_skip; };
struct S5Item { float abr, abi; bf16x8 bf[8]; };
__device__ __forceinline__ void s5_item_setup(const S5Params& P, int g, int lane, LAS unsigned char* wlds, S5Item& L) {
    LAS float* zt = (LAS float*)(wlds + S5_OFF_Z);
    {
        const float lr = P.a_re[g * 64 + lane], li = P.a_im[g * 64 + lane], dt = expf(P.log_dt[g]);
        const float mag = expf(lr * dt);
        L.abr = mag * cosf(li * dt); L.abi = mag * sinf(li * dt);
        const float n_re = L.abr - 1.0f, n_im = L.abi, den = lr * lr + li * li;
        zt[lane * 2] = (n_re * lr + n_im * li) / den; zt[lane * 2 + 1] = (n_im * lr - n_re * li) / den;
    }
    LDS_WAIT(); __builtin_amdgcn_wave_barrier();
    const int i0 = ((lane >> 4) & 1) * 8; const bool lo_half = lane >= 32;
#pragma unroll
    for (int f = 0; f < 8; ++f) {
        const int pp = 16 * f + (lane & 15), p = pp >> 1; const bool im = pp & 1;
        const float zr = zt[p * 2], zi = zt[p * 2 + 1];
        const f32x4* br = (const f32x4*)(P.b_re + (size_t)(g * 64 + p) * 16 + i0); const f32x4* bi = (const f32x4*)(P.b_im + (size_t)(g * 64 + p) * 16 + i0);
        float v[8];
#pragma unroll
        for (int q = 0; q < 2; ++q) { const f32x4 r = br[q], m = bi[q];
#pragma unroll
            for (int j = 0; j < 4; ++j) v[q * 4 + j] = im ? (zr * m[j] + zi * r[j]) : (zr * r[j] - zi * m[j]); }
        u32x4 w;
#pragma unroll
        for (int q = 0; q < 4; ++q) { const unsigned h2 = cvt_pk_bf16(v[2 * q], v[2 * q + 1]);
            const float r0 = v[2 * q] - bflo(h2), r1 = v[2 * q + 1] - bfhi(h2); w[q] = lo_half ? cvt_pk_bf16(r0, r1) : h2; }
        L.bf[f] = __builtin_bit_cast(bf16x8, w);
    }
}
__device__ __forceinline__ u32x2 s5_load_u(const bf16_t* U, int t0, int g, int lane) { if (t0 > T - 16) t0 = T - 16; return *(const u32x2*)(U + (size_t)(t0 + (lane >> 2)) * D + g * 16 + (lane & 3) * 4); }
__device__ __forceinline__ f32x4 s5_u_f32(const u32x2 w) { return (f32x4){bflo(w.x), bfhi(w.x), bflo(w.y), bfhi(w.y)}; }
__device__ __forceinline__ void s5_bu_tile(const S5Item& L, const f32x4 ucur, LAS unsigned char* wlds, int lane) {
    LAS float* ut = (LAS float*)(wlds + S5_OFF_U);
    *(LAS f32x4*)(ut + (lane >> 2) * 16 + (lane & 3) * 4) = ucur;
    LDS_WAIT(); __builtin_amdgcn_wave_barrier();
    const LAS f32x4* up = (const LAS f32x4*)(ut + (lane & 15) * 16 + ((lane >> 4) & 1) * 8);
    const f32x4 u0 = up[0], u1 = up[1];
    u32x4 w; w.x = cvt_pk_bf16(u0[0], u0[1]); w.y = cvt_pk_bf16(u0[2], u0[3]); w.z = cvt_pk_bf16(u1[0], u1[1]); w.w = cvt_pk_bf16(u1[2], u1[3]);
    const bf16x8 uf = __builtin_bit_cast(bf16x8, w);
#pragma unroll
    for (int f = 0; f < 8; ++f) {
        f32x4 d = (f32x4){0.f, 0.f, 0.f, 0.f};
        d = __builtin_amdgcn_mfma_f32_16x16x32_bf16(L.bf[f], uf, d, 0, 0, 0);
        *(LAS f32x4*)(wlds + (lane & 15) * S5_BU_STRIDE + (16 * f + (lane >> 4) * 4) * 4) = d;
    }
    LDS_WAIT(); __builtin_amdgcn_wave_barrier();
}
__device__ __forceinline__ void s5_scan1(LAS unsigned char* lds, const S5Params& P, const bf16_t* U, float* ES, int bid, int G) {
    const int tid = launder(threadIdx.x), lane = tid & 63, wave = __builtin_amdgcn_readfirstlane(tid >> 6), gw = bid * NWAVES + wave, ngw = G * NWAVES;
    LAS unsigned char* wlds = lds + wave * S5_WAVE_LDS;
    for (int item = gw; item < 128 * S5_NC; item += ngw) {
        const int g = item & 127, c = item >> 7;
        S5Item L; s5_item_setup(P, g, lane, wlds, L);
        float sre = 0.f, sim = 0.f;
        u32x2 uq0 = s5_load_u(U, c * S5_L, g, lane), uq1 = s5_load_u(U, c * S5_L + 16, g, lane), uq2 = s5_load_u(U, c * S5_L + 32, g, lane), uq3 = s5_load_u(U, c * S5_L + 48, g, lane);
        for (int t0 = c * S5_L; t0 < (c + 1) * S5_L; t0 += 16) {
            const f32x4 ucur = s5_u_f32(uq0);
            uq0 = uq1; uq1 = uq2; uq2 = uq3; uq3 = s5_load_u(U, t0 + 64, g, lane);
            s5_bu_tile(L, ucur, wlds, lane);
#pragma unroll
            for (int i = 0; i < 16; ++i) { const f32x2 bu = *(const LAS f32x2*)(wlds + i * S5_BU_STRIDE + lane * 8);
                const float nre = L.abr * sre - L.abi * sim + bu[0], nim = L.abr * sim + L.abi * sre + bu[1]; sre = nre; sim = nim; }
            LDS_WAIT(); __builtin_amdgcn_wave_barrier();
        }
        *(f32x2*)(ES + ((size_t)(g * S5_NC + c) * 64 + lane) * 2) = (f32x2){sre, sim};
    }
}
__device__ __forceinline__ void s5_scan2(LAS unsigned char* lds, const S5Params& P, const bf16_t* U, const float* ES, bf16_t* Gb, int bid, int G) {
    const int tid = launder(threadIdx.x), lane = tid & 63, wave = __builtin_amdgcn_readfirstlane(tid >> 6), gw = bid * NWAVES + wave, ngw = G * NWAVES;
    LAS unsigned char* wlds = lds + wave * S5_WAVE_LDS;
    LAS float* ut = (LAS float*)(wlds + S5_OFF_U);
    LAS unsigned char* sb = wlds + S5_OFF_SB;
    const int fr = lane & 15, fq = lane >> 4;
    for (int item = gw; item < 128 * S5_NC; item += ngw) {
        const int g = item & 127, c = item >> 7;
        S5Item L; s5_item_setup(P, g, lane, wlds, L);
        float pr = L.abr, pi = L.abi;
#pragma unroll
        for (int i = 0; i < 8; ++i) { const float nr = pr * pr - pi * pi, ni = 2.0f * pr * pi; pr = nr; pi = ni; }
        float sre = 0.f, sim = 0.f;
        {
            const float* ep = ES + ((size_t)(g * S5_NC) * 64 + lane) * 2; int cc = 0;
            for (; cc + 8 <= c; cc += 8) { f32x2 e[8];
#pragma unroll
                for (int i = 0; i < 8; ++i) e[i] = *(const f32x2*)(ep + (size_t)(cc + i) * 128);
#pragma unroll
                for (int i = 0; i < 8; ++i) { const float nre = pr * sre - pi * sim + e[i][0], nim = pr * sim + pi * sre + e[i][1]; sre = nre; sim = nim; } }
            for (; cc < c; ++cc) { const f32x2 e = *(const f32x2*)(ep + (size_t)cc * 128);
                const float nre = pr * sre - pi * sim + e[0], nim = pr * sim + pi * sre + e[1]; sre = nre; sim = nim; }
        }
        bf16x8 cf[4];
#pragma unroll
        for (int ks = 0; ks < 4; ++ks) { const int p0 = ks * 16 + fq * 4;
            const f32x4 cr = *(const f32x4*)(P.c_re + (size_t)(g * 16 + fr) * 64 + p0), ci = *(const f32x4*)(P.c_im + (size_t)(g * 16 + fr) * 64 + p0);
            u32x4 w; w.x = cvt_pk_bf16(cr[0], -ci[0]); w.y = cvt_pk_bf16(cr[1], -ci[1]); w.z = cvt_pk_bf16(cr[2], -ci[2]); w.w = cvt_pk_bf16(cr[3], -ci[3]);
            cf[ks] = __builtin_bit_cast(bf16x8, w); }
        const f32x4 dsk = *(const f32x4*)(P.d_skip + g * 16 + fq * 4);
        u32x2 uq0 = s5_load_u(U, c * S5_L, g, lane), uq1 = s5_load_u(U, c * S5_L + 16, g, lane), uq2 = s5_load_u(U, c * S5_L + 32, g, lane), uq3 = s5_load_u(U, c * S5_L + 48, g, lane);
        for (int t0 = c * S5_L; t0 < (c + 1) * S5_L; t0 += 16) {
            const f32x4 ucur = s5_u_f32(uq0);
            uq0 = uq1; uq1 = uq2; uq2 = uq3; uq3 = s5_load_u(U, t0 + 64, g, lane);
            s5_bu_tile(L, ucur, wlds, lane);
#pragma unroll
            for (int i = 0; i < 16; ++i) { const f32x2 bu = *(const LAS f32x2*)(wlds + i * S5_BU_STRIDE + lane * 8);
                const float nre = L.abr * sre - L.abi * sim + bu[0], nim = L.abr * sim + L.abi * sre + bu[1]; sre = nre; sim = nim;
                *(LAS unsigned*)(sb + i * S5_SB_STRIDE + lane * 4) = cvt_pk_bf16(sre, sim); }
            LDS_WAIT(); __builtin_amdgcn_wave_barrier();
            f32x4 y = (f32x4){0.f, 0.f, 0.f, 0.f};
#pragma unroll
            for (int ks = 0; ks < 4; ++ks) { const bf16x8 sf = *(const LAS bf16x8*)(sb + fr * S5_SB_STRIDE + ks * 64 + fq * 16);
                y = __builtin_amdgcn_mfma_f32_16x16x32_bf16(cf[ks], sf, y, 0, 0, 0); }
            const f32x4 uu = *(const LAS f32x4*)(ut + fr * 16 + fq * 4);
            u32x2 w; w.x = cvt_pk_bf16(gelu_tanh(y[0] + dsk[0] * uu[0]), gelu_tanh(y[1] + dsk[1] * uu[1])); w.y = cvt_pk_bf16(gelu_tanh(y[2] + dsk[2] * uu[2]), gelu_tanh(y[3] + dsk[3] * uu[3]));
            *(u32x2*)(Gb + (size_t)(t0 + fr) * D + g * 16 + fq * 4) = w;
            LDS_WAIT(); __builtin_amdgcn_wave_barrier();
        }
    }
}

struct Args { const void* in[60]; float* out; unsigned char* ws; };

__global__ void __launch_bounds__(NTHR, 2) mk_fwd(Args args) {
    extern __shared__ __attribute__((aligned(16))) unsigned char lds_raw[];
    LAS unsigned char* lds = (LAS unsigned char*)lds_raw;
    cg::grid_group grid = cg::this_grid();
    const int G = gridDim.x, bid = blockIdx.x;
    unsigned char* ws = args.ws;
    float* out = args.out;
#if USE_XCD_BARRIER
    volatile LAS unsigned* bst = (volatile LAS unsigned*)(lds + LDS_BYTES - 64);
    if (threadIdx.x < 16) bst[threadIdx.x] = 0u;
    __syncthreads();
    (void)xcd_barrier_post((unsigned*)(ws + WS_CTL), bst);
#define GRID_BAR() do { XcdBarrier b_; b_.bar = (unsigned*)(args.ws + WS_CTL); b_.x = xb_xcc_id(); b_.st = (volatile LAS unsigned*)(lds + LDS_BYTES - 64); xcd_barrier(b_); } while (0)
#else
#define GRID_BAR() grid.sync()
#endif
#define INF(i) ((const float*)args.in[(i)])

    bf16_t* HN = (bf16_t*)(ws + WS_HN); bf16_t* PP = (bf16_t*)(ws + WS_PP); bf16_t* PBF = (bf16_t*)(ws + WS_PBF);
    unsigned char* BIG = ws + WS_BIG;

    {
        const int tid = launder(threadIdx.x), lane = tid & 63, wave = __builtin_amdgcn_readfirstlane(tid >> 6);
        const int gw = bid * NWAVES + wave, ngw = G * NWAVES, gtid = bid * NTHR + tid, nthreads = G * NTHR;
        LAS float* scr = (LAS float*)(lds + wave * 16640);
        int base = 0;
        for (int l = 0; l < 4; ++l) {
            if (l == 1) continue;
            const int ib = l == 0 ? 3 : (l == 1 ? 15 : (l == 2 ? 31 : 48));
            const int ic = ib + (l == 1 ? 10 : (l == 2 ? 11 : 6));
            unsigned char* wl = ws + WS_W + (size_t)l * SZ_LAYER_COMMON;
            tr_matrix(INF(ic + 5), PLE, D, (bf16_t*)(wl + WOFF_PLE), 0, 0, scr, lane, gw, ngw, base);
            if (l == 3) continue;
            tr_matrix(INF(ic + 1), D, DFF, (bf16_t*)(wl + WOFF_UP), 0, 0, scr, lane, gw, ngw, base, INF(ic));
            tr_matrix(INF(ic + 2), DFF, D, (bf16_t*)(wl + WOFF_DOWN), 0, 0, scr, lane, gw, ngw, base);
            tr_matrix(INF(ic + 4), D, D, (bf16_t*)(wl + WOFF_PG), 0, 0, scr, lane, gw, ngw, base, INF(ic + 3));
        }
        unsigned char* wm = ws + WS_WMIX;
        tr_matrix(INF(4), D, NQKV, (bf16_t*)(wm + WM_A0_QKV), 0, 0, scr, lane, gw, ngw, base, INF(3));
        tr_matrix(INF(8), D, D, (bf16_t*)(wm + WM_A0_O), 0, 0, scr, lane, gw, ngw, base);
        tr_matrix(INF(49), D, NQKV, (bf16_t*)(wm + WM_A3_QKV), 0, 0, scr, lane, gw, ngw, base, INF(48));
        tr_matrix(INF(53), D, D, (bf16_t*)(wm + WM_A3_O), 0, 0, scr, lane, gw, ngw, base);
        tr_matrix(INF(32), D, D, (bf16_t*)(wm + WM_C_IN), 0, 0, scr, lane, gw, ngw, base, INF(31));
        {
            const float* W = INF(41); bf16_t* WT = (bf16_t*)(wm + WM_C_GLU);
            const int nbk = 2 * D / 64, tiles = (D / 64) * nbk;
            int start = gw - (base % ngw); if (start < 0) start += ngw;
            for (int it = start; it < tiles; it += ngw) { const int kb = it / nbk, n0 = (it % nbk) * 64; const bool gt = n0 >= D;
                tr_tile(W, 2 * D, WT, D, kb * 64, n0, gt ? 2 : 1, gt ? n0 - D : n0, scr, lane); }
            base += tiles;
        }
        const float* pin = INF(1);
        for (int i = gtid; i < 4 * T * PLE / 8; i += nthreads) { const f32x4 a = __builtin_nontemporal_load((const f32x4*)(pin + (size_t)i * 8)), b = __builtin_nontemporal_load((const f32x4*)(pin + (size_t)i * 8 + 4));
            u32x4 w; w.x = cvt_pk_bf16(a[0], a[1]); w.y = cvt_pk_bf16(a[2], a[3]); w.z = cvt_pk_bf16(b[0], b[1]); w.w = cvt_pk_bf16(b[2], b[3]); __builtin_nontemporal_store(w, (u32x4*)(PBF + (size_t)i * 8)); }
    }
    prep_phase(INF(0), HN, (float*)(ws + WS_SSQ0), bid, G);
    grid.sync();

    const int* positions = (const int*)args.in[2];
    bf16_t* HB0 = HN; bf16_t* HB1 = (bf16_t*)(ws + WS_HB1); float* SSQ0 = (float*)(ws + WS_SSQ0); float* SSQ1 = (float*)(ws + WS_SSQ1);
    LAS float* PTAB = (LAS float*)(lds + 131072);
    for (int l = 0; l < 4; ++l) {
        const int kind = l % 3;
        const int ib = l == 0 ? 3 : (l == 1 ? 15 : (l == 2 ? 31 : 48));
        const float* hin = l == 0 ? INF(0) : (const float*)out;
        unsigned char* wl = ws + WS_W + (size_t)l * SZ_LAYER_COMMON;
        unsigned char* wm = ws + WS_WMIX;

        if (kind == 0) {
            bf16_t* QKV = (bf16_t*)(BIG + BG_QKV); bf16_t* AO = (bf16_t*)(BIG + BG_AO);
            const bf16_t* Wqkv = (const bf16_t*)(wm + (l == 0 ? WM_A0_QKV : WM_A3_QKV)); const bf16_t* Wo = (const bf16_t*)(wm + (l == 0 ? WM_A0_O : WM_A3_O));
            { pg8::Gemm g{HB0, Wqkv, T, NQKV, D, D, D, 0, 0}; pg8::StaticOrder S; S.init(T, NQKV, G, bid); pg8::EpiBf16<0> E{QKV, NQKV, SSQ0}; pg8::gemm_phase(lds, g, S, E); }
            {
                int nbusy = (T / 256) * (NQKV / 256) - G; if (nbusy < 0 || nbusy >= G) nbusy = 0;
                if (bid >= nbusy) {
                    if (l == 0) {
                        const int tid = launder(threadIdx.x), lane = tid & 63, wave = __builtin_amdgcn_readfirstlane(tid >> 6);
                        const int gw = (bid - nbusy) * NWAVES + wave, ngw = (G - nbusy) * NWAVES;
                        LAS float* scr = (LAS float*)(lds + wave * 16640);
                        int base = 0; const int zz = launder_s(0);
                        unsigned char* wl1 = ws + WS_W + (size_t)1 * SZ_LAYER_COMMON;
                        tr_matrix(INF(zz + 16), D, 2 * D, (bf16_t*)(wm + WM_B_IN), 0, 0, scr, lane, gw, ngw, base, INF(zz + 15));
                        for (int nb = 0; nb < 8; ++nb) {
                            tr_matrix(INF(zz + 19) + (size_t)nb * 65536, 256, 256, (bf16_t*)(wm + WM_B_G), 1, nb * 256, scr, lane, gw, ngw, base);
                            tr_matrix(INF(zz + 21) + (size_t)nb * 65536, 256, 256, (bf16_t*)(wm + WM_B_G), 2, nb * 256, scr, lane, gw, ngw, base);
                        }
                        tr_matrix(INF(zz + 24), D, D, (bf16_t*)(wm + WM_B_O), 0, 0, scr, lane, gw, ngw, base);
                        tr_matrix(INF(zz + 26), D, DFF, (bf16_t*)(wl1 + WOFF_UP), 0, 0, scr, lane, gw, ngw, base, INF(zz + 25));
                        tr_matrix(INF(zz + 27), DFF, D, (bf16_t*)(wl1 + WOFF_DOWN), 0, 0, scr, lane, gw, ngw, base);
                        tr_matrix(INF(zz + 29), D, D, (bf16_t*)(wl1 + WOFF_PG), 0, 0, scr, lane, gw, ngw, base, INF(zz + 28));
                        tr_matrix(INF(zz + 30), PLE, D, (bf16_t*)(wl1 + WOFF_PLE), 0, 0, scr, lane, gw, ngw, base);
                    } else {
                        pg8::Gemm g{PBF + (size_t)l * T * PLE, (const bf16_t*)(wl + WOFF_PLE), T, D, PLE, PLE, PLE, 0, 0}; pg8::StaticOrder S; S.init(T, D, G - nbusy, bid - nbusy); pg8::EpiBf16<0> E{PP, D, nullptr}; pg8::gemm_phase(lds, g, S, E);
                        const int tid = launder(threadIdx.x), lane = tid & 63, wave = __builtin_amdgcn_readfirstlane(tid >> 6);
                        const int gw = (bid - nbusy) * NWAVES + wave, ngw = (G - nbusy) * NWAVES;
                        LAS float* scr = (LAS float*)(lds + wave * 16640);
                        int base = 0; const int zz = launder_s(0);
                        tr_matrix(INF(zz + 55), D, DFF, (bf16_t*)(wl + WOFF_UP), 0, 0, scr, lane, gw, ngw, base, INF(zz + 54));
                        tr_matrix(INF(zz + 56), DFF, D, (bf16_t*)(wl + WOFF_DOWN), 0, 0, scr, lane, gw, ngw, base);
                        tr_matrix(INF(zz + 58), D, D, (bf16_t*)(wl + WOFF_PG), 0, 0, scr, lane, gw, ngw, base, INF(zz + 57));
                    }
                }
            }
            GRID_BAR();
            attn_phase(lds, QKV, positions, INF(ib + 2), INF(ib + 3), INF(ib + 4), AO, G, bid);
            GRID_BAR();
            { pg8::Gemm g{AO, Wo, T, D, D, D, D, 0, 0}; pg8::StaticOrder S; S.init(T, D, G, bid); pg8::EpiResidual E{hin, out, HB0, SSQ0, PTAB, nullptr}; pg8::gemm_phase(lds, g, S, E); }
            GRID_BAR();
        } else if (kind == 1) {
            bf16_t* XB = (bf16_t*)(BIG + BG_XB); bf16_t* AB = (bf16_t*)(BIG + BG_XB + 32 * MiB); bf16_t* BB = (bf16_t*)(BIG + BG_BB); bf16_t* GATE = (bf16_t*)(BIG + BG_GATE); bf16_t* XC = (bf16_t*)(BIG + BG_XC); bf16_t* Y = HB1;
            float* PE = (float*)(ws + WS_SCAN);
            { pg8::Gemm g{HB0, (const bf16_t*)(wm + WM_B_IN), T, 2 * D, D, D, D, 0, 0}; pg8::StaticOrder S; S.init(T, 2 * D, G, bid); pg8::EpiLruIn E{XB, GATE, SSQ0}; pg8::gemm_phase(lds, g, S, E); }
            GRID_BAR();
            conv_phase(XB, INF(ib + 2), INF(ib + 3), XC, bid, G);
            GRID_BAR();
            { pg8::Gemm g{XC, (const bf16_t*)(wm + WM_B_G), T, 2 * D, 256, D, 256, 1, 256}; pg8::StaticOrder S; S.init(T, 2 * D, G, bid);
              pg8::EpiLruGate E{INF(ib + 5), INF(ib + 7), AB, BB}; pg8::gemm_phase(lds, g, S, E); }
            GRID_BAR();
            lru_scan1(AB, BB, XC, INF(ib + 8), PE, bid, G);
            GRID_BAR();
            lru_scan2(AB, BB, XC, INF(ib + 8), PE, GATE, Y, bid, G);
            GRID_BAR();
            { pg8::Gemm g{Y, (const bf16_t*)(wm + WM_B_O), T, D, D, D, D, 0, 0}; pg8::StaticOrder S; S.init(T, D, G, bid); pg8::EpiResidual E{hin, out, HB0, SSQ0, PTAB, nullptr}; pg8::gemm_phase(lds, g, S, E); }
            GRID_BAR();
        } else {
            bf16_t* U = (bf16_t*)(BIG + BG_U); bf16_t* Gb = (bf16_t*)(BIG + BG_G); float* ES = (float*)(BIG + BG_ES);
            S5Params SP{INF(ib + 2), INF(ib + 3), INF(ib + 4), INF(ib + 5), INF(ib + 6), INF(ib + 7), INF(ib + 8), INF(ib + 9)};
            { pg8::Gemm g{HB0, (const bf16_t*)(wm + WM_C_IN), T, D, D, D, D, 0, 0}; pg8::StaticOrder S; S.init(T, D, G, bid); pg8::EpiBf16<0> E{U, D, SSQ0}; pg8::gemm_phase(lds, g, S, E); }
            GRID_BAR();
            s5_scan1(lds, SP, U, ES, bid, G);
            GRID_BAR();
            s5_scan2(lds, SP, U, ES, Gb, bid, G);
            GRID_BAR();
            { pg8::Gemm g{Gb, (const bf16_t*)(wm + WM_C_GLU), T, 2 * D, D, D, D, 0, 0}; pg8::StaticOrder S; S.init(T, 2 * D, G, bid); pg8::EpiGlu E{out, HB0, SSQ0, PTAB}; pg8::gemm_phase(lds, g, S, E); }
            GRID_BAR();
        }
        {
            bf16_t* UP = (bf16_t*)BIG;
            { pg8::Gemm g{HB0, (const bf16_t*)(wl + WOFF_UP), T, DFF, D, D, D, 0, 0}; pg8::StaticOrder S; S.init(T, DFF, G, bid); pg8::EpiBf16<2> E{UP, DFF, nullptr}; pg8::gemm_phase(lds, g, S, E); }
            if (l != 3) { pg8::Gemm g{PBF + (size_t)l * T * PLE, (const bf16_t*)(wl + WOFF_PLE), T, D, PLE, PLE, PLE, 0, 0}; pg8::StaticOrder S; S.init(T, D, G, bid); pg8::EpiBf16<0> E{PP, D, nullptr}; pg8::gemm_phase(lds, g, S, E); }
            GRID_BAR();
            { pg8::Gemm g{UP, (const bf16_t*)(wl + WOFF_DOWN), T, D, DFF, DFF, DFF, 0, 0}; pg8::StaticOrder S; S.init(T, D, G, bid); pg8::EpiResidual E{out, out, HB1, SSQ1, PTAB, SSQ0}; pg8::gemm_phase(lds, g, S, E); }
            GRID_BAR();
        }
        if (l < 3) { pg8::Gemm g{HB1, (const bf16_t*)(wl + WOFF_PG), T, D, D, D, D, 0, 0}; pg8::StaticOrder S; S.init(T, D, G, bid); pg8::EpiPle<false> E{PP, out, SSQ1, HB0, SSQ0, PTAB}; pg8::gemm_phase(lds, g, S, E); }
        else       { pg8::Gemm g{HB1, (const bf16_t*)(wl + WOFF_PG), T, D, D, D, D, 0, 0}; pg8::StaticOrder S; S.init(T, D, G, bid); pg8::EpiPle<true> E{PP, out, SSQ1, HB0, SSQ0, PTAB}; pg8::gemm_phase(lds, g, S, E); }
        if (l < 3) GRID_BAR();
    }
}

extern "C" void kernel_launch(void* const* d_in, const int* in_sizes, int n_in, void* d_out, int out_size, void* d_ws, size_t ws_size, hipStream_t stream) {
    static int grid = 0;
    if (grid == 0) {
        if (n_in != 60 || out_size != T * D || ws_size < WS_END) { fprintf(stderr, "kernel_launch: unexpected shapes: n_in %d out %d ws %zu (need %zu)\n", n_in, out_size, ws_size, (size_t)WS_END); grid = -1; return; }
        int dev = 0, cus = 0, per_cu = 0;
        if (hipGetDevice(&dev) != hipSuccess || hipDeviceGetAttribute(&cus, hipDeviceAttributeMultiprocessorCount, dev) != hipSuccess) { grid = -1; return; }
        if (hipFuncSetAttribute((const void*)mk_fwd, hipFuncAttributeMaxDynamicSharedMemorySize, LDS_BYTES) != hipSuccess) { fprintf(stderr, "kernel_launch: hipFuncSetAttribute failed\n"); grid = -1; return; }
        if (hipOccupancyMaxActiveBlocksPerMultiprocessor(&per_cu, (const void*)mk_fwd, NTHR, LDS_BYTES) != hipSuccess || per_cu < 1) { fprintf(stderr, "kernel_launch: occupancy query says %d\n", per_cu); per_cu = 1; }
        (void)hipGetLastError();
        grid = cus * 1;
    }
    if (grid < 0) return;
    (void)hipMemsetAsync((char*)d_ws + WS_CTL, 0, CTL_ZERO_BYTES, stream);
    Args a{};
    for (int i = 0; i < 60; ++i) a.in[i] = d_in[i];
    a.out = (float*)d_out; a.ws = (unsigned char*)d_ws;
    void* params[] = {&a};
    hipError_t e = hipLaunchCooperativeKernel((const void*)mk_fwd, dim3(grid), dim3(NTHR), params, LDS_BYTES, stream);
    if (e != hipSuccess) fprintf(stderr, "kernel_launch: cooperative launch failed: %s (grid %d)\n", hipGetErrorString(e), grid);
}
```

```cpp
#include <hip/hip_runtime.h>
#include <hip/hip_cooperative_groups.h>
#include <cstdio>
#include <cstdint>
namespace cg = cooperative_groups;

#ifndef USE_XCD_BARRIER
#define USE_XCD_BARRIER 1
#endif

#define GAS __attribute__((address_space(1)))
#define LAS __attribute__((address_space(3)))
typedef unsigned short bf16_t;
typedef short bf16x8 __attribute__((ext_vector_type(8)));
typedef float f32x4 __attribute__((ext_vector_type(4)));
typedef float f32x2 __attribute__((ext_vector_type(2)));
typedef unsigned u32x4 __attribute__((ext_vector_type(4)));
typedef unsigned u32x2 __attribute__((ext_vector_type(2)));

constexpr int T = 8192, D = 2048, DFF = 8192, NQKV = 2560, PLE = 256;
constexpr float EPS = 1e-6f;
constexpr int PAD_POS = -(1 << 20);
constexpr int NWAVES = 8, NTHR = 512;

typedef __bf16 bf16v2_t __attribute__((ext_vector_type(2)));
__device__ __forceinline__ unsigned cvt_pk_bf16(float lo, float hi) { bf16v2_t v; v.x = (__bf16)lo; v.y = (__bf16)hi; return __builtin_bit_cast(unsigned, v); }
__device__ __forceinline__ float bf2f(unsigned short b) { return __builtin_bit_cast(float, (unsigned)b << 16); }
__device__ __forceinline__ float bflo(unsigned w) { return __builtin_bit_cast(float, w << 16); }
__device__ __forceinline__ float bfhi(unsigned w) { return __builtin_bit_cast(float, w & 0xffff0000u); }
__device__ __forceinline__ float sigmoidf_(float x) { return __builtin_amdgcn_rcpf(1.0f + __expf(-x)); }
__device__ __forceinline__ float gelu_tanh(float x) { const float z = 0.7978845608028654f * (x + 0.044715f * x * x * x); return x * __builtin_amdgcn_rcpf(1.0f + __expf(-2.0f * z)); }
__device__ __forceinline__ float shx(float v, int o, int lane) { return __builtin_bit_cast(float, __builtin_amdgcn_ds_bpermute((lane ^ o) << 2, __builtin_bit_cast(int, v))); }
__device__ __forceinline__ float wave_sum(float v, int lane) {
#pragma unroll
    for (int o = 1; o < 64; o <<= 1) v += shx(v, o, lane);
    return v;
}
#define LDS_WAIT() asm volatile("s_waitcnt lgkmcnt(0)" ::: "memory")
__device__ __forceinline__ int launder(int v) { asm volatile("" : "+v"(v)); return v; }
__device__ __forceinline__ int launder_s(int v) { asm volatile("" : "+s"(v)); return v; }

namespace pg8 {
constexpr int BM = 256, BK = 64, HALF = 128, HTB = HALF * BK * 2, STAGE_BYTES = 8 * HTB, NXCD = 8, WGM = 8;
__host__ __device__ __forceinline__ int lds_byte(int r, int c) { const int st = (r >> 4) * 2 + (c >> 5), rr = r & 15, cc = c & 31, ob = rr * 64 + cc * 2; return st * 1024 + (ob ^ (((ob >> 9) & 1) << 5)); }
__host__ __device__ __forceinline__ void stage_rc(int b, int& R, int& C) { const int st = b / 1024, sb = b % 1024, swz = sb ^ (((sb >> 9) & 1) << 5); R = (st >> 1) * 16 + swz / 64; C = (st & 1) * 32 + (swz % 64) / 2; }
__host__ __device__ __forceinline__ int perm32(int rho) { const int n = rho >> 4, i = rho & 15; return 8 * (i >> 2) + 4 * n + (i & 3); }

struct Unit { int pm, pn; };
struct Gemm { const bf16_t* A; const bf16_t* Bt; int M, N, K, lda, ldb, acol_shift, acol_mul; };

struct StaticOrder {
    int nM, nN, nwg, G, c;
    __device__ void init(int M, int N, int G_, int c_) { nM = M / BM; nN = N / BM; nwg = nM * nN; G = launder_s(G_); c = launder_s(c_); }
    __device__ bool next(int i, Unit& u) const {
        const long L = (long)i * G + c; if (L >= nwg) return false;
        int wgid = (int)L; { const int q = nwg / NXCD, r = nwg % NXCD, xcd = wgid % NXCD, off = wgid / NXCD; wgid = (xcd < r ? xcd * (q + 1) : r * (q + 1) + (xcd - r) * q) + off; }
        const int nig = WGM * nN, gid = wgid / nig, fm = gid * WGM, gsz = (nM - fm) < WGM ? (nM - fm) : WGM;
        u.pm = fm + ((wgid % nig) % gsz); u.pn = (wgid % nig) / gsz; return true;
    }
};

__device__ __forceinline__ float row_rstd(const float* ssq, int row) {
    const f32x4* p = (const f32x4*)(ssq + (size_t)row * 16); const f32x4 a = p[0], b = p[1], c = p[2], d = p[3];
    return rsqrtf(((((a[0] + a[1]) + (a[2] + a[3])) + ((b[0] + b[1]) + (b[2] + b[3]))) + (((c[0] + c[1]) + (c[2] + c[3])) + ((d[0] + d[1]) + (d[2] + d[3])))) * (1.0f / 2048.0f) + 1e-6f);
}
template <bool SIXTEEN> __device__ __forceinline__ void tile_ssq(const float (&s)[2][4], const Unit& u, int wr, int wc, int fr, int fq, float* ssq, LAS float* ptab) {
    const int lane = fq * 16 + fr;
#pragma unroll
    for (int ai = 0; ai < 2; ++ai)
#pragma unroll
        for (int m = 0; m < 4; ++m) { float v = s[ai][m]; v += shx(v, 16, lane); v += shx(v, 32, lane); if (fq == 0) ptab[(ai * HALF + wr * 64 + m * 16 + fr) * 4 + wc] = v; }
    asm volatile("s_waitcnt lgkmcnt(0)" ::: "memory"); __builtin_amdgcn_s_barrier(); asm volatile("" ::: "memory");
    const int t = wr * 256 + wc * 64 + lane;
    if (t < 256) { const f32x4 p = *(const LAS f32x4*)(ptab + t * 4); float* q = ssq + (size_t)(u.pm * BM + t) * 16 + u.pn; q[0] = (p[0] + p[1]) + (p[2] + p[3]); if (!SIXTEEN) q[8] = 0.f; }
}
__device__ __forceinline__ void rows_rstd(const float* ssq, int row0  , int fr, int fq, float (&rs)[8]) {
    const int lane = fq * 16 + fr; f32x4 p[8];
    const float* b0 = ssq + (size_t)row0 * 16 + fq * 4;
#pragma unroll
    for (int r = 0; r < 8; ++r) p[r] = *(const f32x4*)(b0 + (r >> 2) * (HALF * 16) + (r & 3) * 256);
#pragma unroll
    for (int r = 0; r < 8; ++r) { float v = (p[r][0] + p[r][1]) + (p[r][2] + p[r][3]); v += shx(v, 16, lane); v += shx(v, 32, lane); rs[r] = rsqrtf(v * (1.0f / 2048.0f) + 1e-6f); }
}
__device__ __forceinline__ float ssq4(const f32x4 o) { return (o[0] * o[0] + o[1] * o[1]) + (o[2] * o[2] + o[3] * o[3]); }

template <int ACT  > struct EpiBf16 {
    static constexpr bool PERM = true;
    bf16_t* O; int ldc; const float* ssq;
    __device__ __forceinline__ void operator()(f32x4 (&acc)[2][2][4][2], const Unit& u, int wr, int wc, int fr, int fq) const {
        const int row0 = u.pm * BM + wr * 64 + fr; const int col0 = u.pn * BM + wc * 32 + 8 * fq;
        float rsv[8]; if (ssq) rows_rstd(ssq, row0, fr, fq, rsv);
#pragma unroll
        for (int ai = 0; ai < 2; ++ai)
#pragma unroll
            for (int m = 0; m < 4; ++m) { const int row = row0 + ai * HALF + m * 16; bf16_t* rowp = O + (size_t)row * ldc + col0;
                const float rs = ssq ? rsv[ai * 4 + m] : 1.0f;
#pragma unroll
                for (int bj = 0; bj < 2; ++bj) { f32x4 v0 = acc[ai][bj][m][0] * rs, v1 = acc[ai][bj][m][1] * rs;
                    if (ACT == 2) {
#pragma unroll
                        for (int j = 0; j < 4; ++j) { float a = v0[j] > 0.f ? v0[j] : 0.f; v0[j] = a * a; float b = v1[j] > 0.f ? v1[j] : 0.f; v1[j] = b * b; } }
                    u32x4 w; w.x = cvt_pk_bf16(v0[0], v0[1]); w.y = cvt_pk_bf16(v0[2], v0[3]); w.z = cvt_pk_bf16(v1[0], v1[1]); w.w = cvt_pk_bf16(v1[2], v1[3]);
                    *(u32x4*)(rowp + bj * HALF) = w; } }
    }
};
struct EpiF32 {
    static constexpr bool PERM = false;
    float* O; int ldc; const float* ssq;
    __device__ __forceinline__ void operator()(f32x4 (&acc)[2][2][4][2], const Unit& u, int wr, int wc, int fr, int fq) const {
        const int col0 = u.pn * BM + wc * 32 + 4 * fq;
        float rsv[8]; if (ssq) rows_rstd(ssq, u.pm * BM + wr * 64 + fr, fr, fq, rsv);
#pragma unroll
        for (int ai = 0; ai < 2; ++ai)
#pragma unroll
            for (int m = 0; m < 4; ++m) { const int row = u.pm * BM + ai * HALF + wr * 64 + m * 16 + fr; const size_t off = (size_t)row * ldc + col0;
                const float rs = ssq ? rsv[ai * 4 + m] : 1.0f;
#pragma unroll
                for (int bj = 0; bj < 2; ++bj)
#pragma unroll
                    for (int n = 0; n < 2; ++n) *(f32x4*)(O + off + bj * HALF + n * 16) = acc[ai][bj][m][n] * rs; }
    }
};
#define EPI_ROW(r) (u.pm * BM + ((r) >> 2) * HALF + wr * 64 + ((r) & 3) * 16 + fr)
struct EpiResidual {
    static constexpr bool PERM = true;
    const float* base; float* out; bf16_t* hb; float* ssq; LAS float* ptab; const float* ssq_scale;
    __device__ __forceinline__ void operator()(f32x4 (&acc)[2][2][4][2], const Unit& u, int wr, int wc, int fr, int fq) const {
        const int col0 = u.pn * BM + wc * 32 + 8 * fq;
        float s[2][4];
        if (ssq_scale) { float rsv[8]; rows_rstd(ssq_scale, u.pm * BM + wr * 64 + fr, fr, fq, rsv);
#pragma unroll
            for (int r = 0; r < 8; ++r) { const float rs2 = rsv[r] * rsv[r];
#pragma unroll
                for (int c = 0; c < 4; ++c) acc[r >> 2][c >> 1][r & 3][c & 1] = acc[r >> 2][c >> 1][r & 3][c & 1] * rs2; } }
        f32x4 cur[2][4], nxt[2][4];
#pragma unroll
        for (int q = 0; q < 2; ++q)
#pragma unroll
            for (int c = 0; c < 4; ++c) cur[q][c] = *(const f32x4*)(base + (size_t)EPI_ROW(q) * D + col0 + (c >> 1) * HALF + (c & 1) * 4);
#pragma unroll
        for (int k = 0; k < 4; ++k) {
            if (k < 3) {
#pragma unroll
                for (int q = 0; q < 2; ++q)
#pragma unroll
                    for (int c = 0; c < 4; ++c) nxt[q][c] = *(const f32x4*)(base + (size_t)EPI_ROW(2 * k + 2 + q) * D + col0 + (c >> 1) * HALF + (c & 1) * 4);
            }
            asm volatile("" ::: "memory");
#pragma unroll
            for (int q = 0; q < 2; ++q) { const int r = 2 * k + q, ai = r >> 2, m = r & 3; const size_t off = (size_t)EPI_ROW(r) * D + col0; float sr = 0.f;
#pragma unroll
                for (int bj = 0; bj < 2; ++bj) { const f32x4 o0 = cur[q][2 * bj] + acc[ai][bj][m][0], o1 = cur[q][2 * bj + 1] + acc[ai][bj][m][1];
                    *(f32x4*)(out + off + bj * HALF) = o0; *(f32x4*)(out + off + bj * HALF + 4) = o1;
                    u32x4 w; w.x = cvt_pk_bf16(o0[0], o0[1]); w.y = cvt_pk_bf16(o0[2], o0[3]); w.z = cvt_pk_bf16(o1[0], o1[1]); w.w = cvt_pk_bf16(o1[2], o1[3]); *(u32x4*)(hb + off + bj * HALF) = w; sr += ssq4(o0) + ssq4(o1); }
                s[ai][m] = sr; }
            asm volatile("" ::: "memory");
#pragma unroll
            for (int q = 0; q < 2; ++q)
#pragma unroll
                for (int c = 0; c < 4; ++c) cur[q][c] = nxt[q][c];
        }
        tile_ssq<false>(s, u, wr, wc, fr, fq, ssq, ptab);
    }
};
template <bool LAST  > struct EpiPle {
    static constexpr bool PERM = true;
    const bf16_t* pp; float* h; const float* ssq_in; bf16_t* hb; float* ssq_out; LAS float* ptab;
    __device__ __forceinline__ void operator()(f32x4 (&acc)[2][2][4][2], const Unit& u, int wr, int wc, int fr, int fq) const {
        const int col0 = u.pn * BM + wc * 32 + 8 * fq;
        float s[2][4];
        { float rsv[8]; rows_rstd(ssq_in, u.pm * BM + wr * 64 + fr, fr, fq, rsv);
#pragma unroll
            for (int r = 0; r < 8; ++r)
#pragma unroll
                for (int c = 0; c < 4; ++c) acc[r >> 2][c >> 1][r & 3][c & 1] = acc[r >> 2][c >> 1][r & 3][c & 1] * rsv[r]; }
        f32x4 cur[2][4], nxt[2][4]; u32x2 pcur[4], pnxt[4];
#pragma unroll
        for (int q = 0; q < 2; ++q)
#pragma unroll
            for (int c = 0; c < 4; ++c) cur[q][c] = *(const f32x4*)(h + (size_t)EPI_ROW(q) * D + col0 + (c >> 1) * HALF + (c & 1) * 4);
#pragma unroll
        for (int c = 0; c < 4; ++c) pcur[c] = *(const u32x2*)(pp + (size_t)EPI_ROW(0) * D + col0 + (c >> 1) * HALF + (c & 1) * 4);
#pragma unroll
        for (int k = 0; k < 4; ++k) {
            if (k < 3) {
#pragma unroll
                for (int q = 0; q < 2; ++q)
#pragma unroll
                    for (int c = 0; c < 4; ++c) nxt[q][c] = *(const f32x4*)(h + (size_t)EPI_ROW(2 * k + 2 + q) * D + col0 + (c >> 1) * HALF + (c & 1) * 4);
            }
#pragma unroll
            for (int q = 0; q < 2; ++q) { const int r = 2 * k + q, ai = r >> 2, m = r & 3; const size_t off = (size_t)EPI_ROW(r) * D + col0; float sr = 0.f;
                if (r < 7) {
#pragma unroll
                    for (int c = 0; c < 4; ++c) pnxt[c] = *(const u32x2*)(pp + (size_t)EPI_ROW(r + 1) * D + col0 + (c >> 1) * HALF + (c & 1) * 4);
                }
                asm volatile("" ::: "memory");
#pragma unroll
                for (int bj = 0; bj < 2; ++bj) { f32x4 o2[2];
#pragma unroll
                    for (int n = 0; n < 2; ++n) { const f32x4 b = cur[q][2 * bj + n]; const u32x2 qw = pcur[2 * bj + n];
                        const f32x4 pq = (f32x4){bflo(qw.x), bfhi(qw.x), bflo(qw.y), bfhi(qw.y)}; const f32x4 a = acc[ai][bj][m][n];
#pragma unroll
                        for (int j = 0; j < 4; ++j) o2[n][j] = b[j] + pq[j] * sigmoidf_(a[j]); }
                    *(f32x4*)(h + off + bj * HALF) = o2[0]; *(f32x4*)(h + off + bj * HALF + 4) = o2[1];
                    if (!LAST) { u32x4 w; w.x = cvt_pk_bf16(o2[0][0], o2[0][1]); w.y = cvt_pk_bf16(o2[0][2], o2[0][3]); w.z = cvt_pk_bf16(o2[1][0], o2[1][1]); w.w = cvt_pk_bf16(o2[1][2], o2[1][3]);
                        *(u32x4*)(hb + off + bj * HALF) = w; sr += ssq4(o2[0]) + ssq4(o2[1]); } }
                s[ai][m] = sr;
                asm volatile("" ::: "memory");
#pragma unroll
                for (int c = 0; c < 4; ++c) pcur[c] = pnxt[c];
            }
#pragma unroll
            for (int q = 0; q < 2; ++q)
#pragma unroll
                for (int c = 0; c < 4; ++c) cur[q][c] = nxt[q][c];
        }
        if (!LAST) tile_ssq<false>(s, u, wr, wc, fr, fq, ssq_out, ptab);
    }
};
struct EpiLruIn {
    static constexpr bool PERM = false;
    bf16_t* xb; bf16_t* gate; const float* ssq;
    __device__ __forceinline__ void operator()(f32x4 (&acc)[2][2][4][2], const Unit& u, int wr, int wc, int fr, int fq) const {
        const bool isg = u.pn >= 8; const int col0 = (u.pn & 7) * BM + wc * 32 + 4 * fq;
        float rsv[8]; rows_rstd(ssq, u.pm * BM + wr * 64 + fr, fr, fq, rsv);
#pragma unroll
        for (int ai = 0; ai < 2; ++ai)
#pragma unroll
            for (int m = 0; m < 4; ++m) { const int row = u.pm * BM + ai * HALF + wr * 64 + m * 16 + fr; const size_t off = (size_t)row * D + col0;
                const float rs = rsv[ai * 4 + m];
#pragma unroll
                for (int bj = 0; bj < 2; ++bj)
#pragma unroll
                    for (int n = 0; n < 2; ++n) { const f32x4 a = acc[ai][bj][m][n] * rs;
                        if (isg) { u32x2 w; w.x = cvt_pk_bf16(gelu_tanh(a[0]), gelu_tanh(a[1])); w.y = cvt_pk_bf16(gelu_tanh(a[2]), gelu_tanh(a[3])); *(u32x2*)(gate + off + bj * HALF + n * 16) = w; }
                        else { u32x2 w; w.x = cvt_pk_bf16(a[0], a[1]); w.y = cvt_pk_bf16(a[2], a[3]); *(u32x2*)(xb + off + bj * HALF + n * 16) = w; } } }
    }
};
struct EpiLruGate {
    static constexpr bool PERM = false;
    const float* ba; const float* bx; bf16_t* Rbuf; bf16_t* Ibuf;
    __device__ __forceinline__ void operator()(f32x4 (&acc)[2][2][4][2], const Unit& u, int wr, int wc, int fr, int fq) const {
        const int ch0 = u.pn * HALF + wc * 32 + 4 * fq;
#pragma unroll
        for (int ai = 0; ai < 2; ++ai)
#pragma unroll
            for (int m = 0; m < 4; ++m) { const size_t off = (size_t)(u.pm * BM + ai * HALF + wr * 64 + m * 16 + fr) * D + ch0;
#pragma unroll
                for (int n = 0; n < 2; ++n) {
                    const f32x4 ra = acc[ai][0][m][n] + *(const f32x4*)(ba + ch0 + n * 16), rx = acc[ai][1][m][n] + *(const f32x4*)(bx + ch0 + n * 16);
                    u32x2 w0, w1; w0.x = cvt_pk_bf16(sigmoidf_(ra[0]), sigmoidf_(ra[1])); w0.y = cvt_pk_bf16(sigmoidf_(ra[2]), sigmoidf_(ra[3]));
                    w1.x = cvt_pk_bf16(sigmoidf_(rx[0]), sigmoidf_(rx[1])); w1.y = cvt_pk_bf16(sigmoidf_(rx[2]), sigmoidf_(rx[3]));
                    *(u32x2*)(Rbuf + off + n * 16) = w0; *(u32x2*)(Ibuf + off + n * 16) = w1; }
                asm volatile("" ::: "memory"); }
    }
};
struct EpiGlu {
    static constexpr bool PERM = false;
    float* h; bf16_t* hb; float* ssq; LAS float* ptab;
    __device__ __forceinline__ void operator()(f32x4 (&acc)[2][2][4][2], const Unit& u, int wr, int wc, int fr, int fq) const {
        const int ch0 = u.pn * HALF + wc * 32 + 4 * fq;
        float s[2][4];
        f32x4 cur[4][2], nxt[4][2];
#pragma unroll
        for (int q = 0; q < 4; ++q)
#pragma unroll
            for (int n = 0; n < 2; ++n) cur[q][n] = *(const f32x4*)(h + (size_t)EPI_ROW(q) * D + ch0 + n * 16);
#pragma unroll
        for (int k = 0; k < 2; ++k) {
            if (k < 1) {
#pragma unroll
                for (int q = 0; q < 4; ++q)
#pragma unroll
                    for (int n = 0; n < 2; ++n) nxt[q][n] = *(const f32x4*)(h + (size_t)EPI_ROW(4 + q) * D + ch0 + n * 16);
            }
            asm volatile("" ::: "memory");
#pragma unroll
            for (int q = 0; q < 4; ++q) { const int r = 4 * k + q, ai = r >> 2, m = r & 3; const size_t off = (size_t)EPI_ROW(r) * D + ch0; float sr = 0.f;
#pragma unroll
                for (int n = 0; n < 2; ++n) { const f32x4 b = cur[q][n]; const f32x4 v = acc[ai][0][m][n], g = acc[ai][1][m][n]; f32x4 o;
#pragma unroll
                    for (int j = 0; j < 4; ++j) o[j] = b[j] + v[j] * sigmoidf_(g[j]);
                    *(f32x4*)(h + off + n * 16) = o; u32x2 w; w.x = cvt_pk_bf16(o[0], o[1]); w.y = cvt_pk_bf16(o[2], o[3]); *(u32x2*)(hb + off + n * 16) = w; sr += ssq4(o); }
                s[ai][m] = sr; }
            asm volatile("" ::: "memory");
#pragma unroll
            for (int q = 0; q < 4; ++q)
#pragma unroll
                for (int n = 0; n < 2; ++n) cur[q][n] = nxt[q][n];
        }
        tile_ssq<true>(s, u, wr, wc, fr, fq, ssq, ptab);
    }
};
#undef EPI_ROW

template <class Epi>
__device__ __forceinline__ void gemm_phase(LAS unsigned char* lds, const Gemm g, const StaticOrder& S, const Epi& E) {
    const int tid = launder(threadIdx.x), wid = __builtin_amdgcn_readfirstlane(tid >> 6), lane = tid & 63, wr = wid >> 2, wc = wid & 3, fr = lane & 15, fq = lane >> 4;
    const int K = g.K, nt = K / BK;
    unsigned voffA[2], voffB[2];
#pragma unroll
    for (int i = 0; i < 2; ++i) { int R, C; stage_rc(tid * 16 + i * 8192, R, C); const int Rb = Epi::PERM ? ((R & ~31) + perm32(R & 31)) : R;
        voffA[i] = (unsigned)(R * g.lda + C) * 2u; voffB[i] = (unsigned)(Rb * g.ldb + C) * 2u; }
    const size_t kstep = (size_t)(BK * 2);
    const size_t hstepA = (size_t)HALF * g.lda * 2, hstepB = (size_t)HALF * g.ldb * 2;
    const size_t tstepA = 2 * hstepA, tstepB = 2 * hstepB;
    const unsigned ldsw = (unsigned)wid * 1024u;
    const int aoff = lds_byte(wr * 64 + fr, fq * 8), boff = lds_byte(wc * 32 + fr, fq * 8);
#define PG8_UA(u) ((const char*)g.A + (size_t)(u).pm * tstepA + (size_t)(((u).pn >> g.acol_shift) * g.acol_mul) * 2)
#define PG8_UB(u) ((const char*)g.Bt + (size_t)(u).pn * tstepB)
#define PG8_SA(b, h) (((b) * 2 + (h)) * HTB)
#define PG8_SB(b, h) ((4 + (b) * 2 + (h)) * HTB)
#define PG8_STAGE(bufoff, gbase, voff) do { _Pragma("unroll") for (int _i = 0; _i < 2; ++_i) \
        __builtin_amdgcn_global_load_lds((const unsigned*)((const char*)(gbase) + (voff)[_i]), (LAS unsigned*)(lds + (bufoff) + ldsw + _i * 8192), 16, 0, 0); } while (0)
#define PG8_LDA(dst, b, h) do { _Pragma("unroll") for (int m = 0; m < 4; ++m) _Pragma("unroll") for (int k = 0; k < 2; ++k) dst[m][k] = *(const LAS bf16x8*)(lds + PG8_SA(b, h) + aoff + m * 2048 + k * 1024); } while (0)
#define PG8_LDB(dst, b, h) do { _Pragma("unroll") for (int n = 0; n < 2; ++n) _Pragma("unroll") for (int k = 0; k < 2; ++k) dst[n][k] = *(const LAS bf16x8*)(lds + PG8_SB(b, h) + boff + n * 2048 + k * 1024); } while (0)
#define PG8_MMA(ai, bj, At, Bt) do { __builtin_amdgcn_s_setprio(1); _Pragma("unroll") for (int m = 0; m < 4; ++m) _Pragma("unroll") for (int n = 0; n < 2; ++n) _Pragma("unroll") for (int k = 0; k < 2; ++k) \
        acc[ai][bj][m][n] = __builtin_amdgcn_mfma_f32_16x16x32_bf16(Bt[n][k], At[m][k], acc[ai][bj][m][n], 0, 0, 0); __builtin_amdgcn_s_setprio(0); } while (0)
#define PG8_WAIT_V(n) asm volatile("s_waitcnt vmcnt(" #n ")" ::: "memory")
#define PG8_WAIT_L(n) asm volatile("s_waitcnt lgkmcnt(" #n ")" ::: "memory")
#define PG8_BAR __builtin_amdgcn_s_barrier()
#define PG8_SCHED __builtin_amdgcn_sched_barrier(0)
    Unit cur, nxt; int ui = 0;
    if (!S.next(0, cur)) return;
    f32x4 acc[2][2][4][2];
#pragma unroll
    for (int a = 0; a < 2; ++a)
#pragma unroll
        for (int b = 0; b < 2; ++b)
#pragma unroll
            for (int m = 0; m < 4; ++m)
#pragma unroll
                for (int n = 0; n < 2; ++n) acc[a][b][m][n] = (f32x4){0.f, 0.f, 0.f, 0.f};
    bf16x8 At[4][2], B0[2][2], B1[2][2];
    const char* cA = PG8_UA(cur); const char* cB = PG8_UB(cur);
    PG8_STAGE(PG8_SB(0, 0), cB, voffB); PG8_STAGE(PG8_SB(0, 1), cB + hstepB, voffB); PG8_STAGE(PG8_SA(0, 0), cA, voffA); PG8_STAGE(PG8_SA(0, 1), cA + hstepA, voffA);
    if (wr == 1) PG8_BAR;
    PG8_WAIT_V(2); PG8_BAR;
    PG8_STAGE(PG8_SB(1, 0), cB + kstep, voffB); PG8_STAGE(PG8_SA(1, 0), cA + kstep, voffA); PG8_STAGE(PG8_SB(1, 1), cB + hstepB + kstep, voffB);
    PG8_WAIT_V(6); PG8_BAR;
    for (;;) {
        const bool has_next = S.next(ui + 1, nxt);
        const char* nA = has_next ? PG8_UA(nxt) : cA; const char* nB = has_next ? PG8_UB(nxt) : cB;
        for (int t = 0; t < nt; t += 2) {
            const bool last = (t == nt - 2);
            const char* a1 = cA + (size_t)(t + 1) * kstep;
            const char* a2 = last ? nA : cA + (size_t)(t + 2) * kstep; const char* b2 = last ? nB : cB + (size_t)(t + 2) * kstep;
            const char* a3 = a2 + kstep; const char* b3 = b2 + kstep;
            PG8_LDB(B0, 0, 0); PG8_LDB(B1, 0, 1); PG8_SCHED; PG8_LDA(At, 0, 0); PG8_STAGE(PG8_SA(1, 1), a1 + hstepA, voffA);
            PG8_WAIT_V(8); PG8_WAIT_L(0); PG8_BAR; PG8_MMA(0, 0, At, B0); PG8_MMA(0, 1, At, B1); PG8_BAR; PG8_SCHED;
            PG8_LDA(At, 0, 1); PG8_STAGE(PG8_SB(0, 0), b2, voffB); PG8_STAGE(PG8_SB(0, 1), b2 + hstepB, voffB); PG8_STAGE(PG8_SA(0, 0), a2, voffA);
            PG8_WAIT_V(8); PG8_WAIT_L(0); PG8_BAR; PG8_MMA(1, 0, At, B0); PG8_MMA(1, 1, At, B1); PG8_BAR; PG8_SCHED;
            PG8_LDB(B0, 1, 0); PG8_LDB(B1, 1, 1); PG8_SCHED; PG8_LDA(At, 1, 0); PG8_STAGE(PG8_SA(0, 1), a2 + hstepA, voffA);
            PG8_WAIT_V(8); PG8_WAIT_L(0); PG8_BAR; PG8_MMA(0, 0, At, B0); PG8_MMA(0, 1, At, B1); PG8_BAR; PG8_SCHED;
            PG8_LDA(At, 1, 1); PG8_STAGE(PG8_SB(1, 0), b3, voffB); PG8_STAGE(PG8_SB(1, 1), b3 + hstepB, voffB); PG8_STAGE(PG8_SA(1, 0), a3, voffA);
            PG8_WAIT_V(8); PG8_WAIT_L(0); PG8_BAR; PG8_MMA(1, 0, At, B0); PG8_MMA(1, 1, At, B1); PG8_BAR; PG8_SCHED;
        }
        if (wr == 0) PG8_BAR;
        { const int l2 = launder(threadIdx.x) & 63; E(acc, cur, wr, wc, l2 & 15, l2 >> 4); }
        if (!has_next) break;
#pragma unroll
        for (int a = 0; a < 2; ++a)
#pragma unroll
            for (int b = 0; b < 2; ++b)
#pragma unroll
                for (int m = 0; m < 4; ++m)
#pragma unroll
                    for (int n = 0; n < 2; ++n) acc[a][b][m][n] = (f32x4){0.f, 0.f, 0.f, 0.f};
        cur = nxt; cA = nA; cB = nB; ++ui;
        if (wr == 1) PG8_BAR;
    }
    PG8_WAIT_V(0);
    PG8_BAR;
#undef PG8_UA
#undef PG8_UB
#undef PG8_SA
#undef PG8_SB
#undef PG8_STAGE
#undef PG8_LDA
#undef PG8_LDB
#undef PG8_MMA
#undef PG8_WAIT_V
#undef PG8_WAIT_L
#undef PG8_BAR
#undef PG8_SCHED
}
}

constexpr size_t MiB = 1u << 20;
constexpr size_t WS_CTL = 0, CTL_ZERO_BYTES = 64 * 1024;
constexpr size_t SZ_UP = (size_t)D * DFF * 2, SZ_DD = (size_t)D * D * 2, SZ_PLE = (size_t)PLE * D * 2;
constexpr size_t SZ_LAYER_COMMON = 2 * SZ_UP + SZ_DD + SZ_PLE;
constexpr size_t WS_W = 1 * MiB;
constexpr size_t WOFF_UP = 0, WOFF_DOWN = SZ_UP, WOFF_PG = 2 * SZ_UP, WOFF_PLE = 2 * SZ_UP + SZ_DD;
constexpr size_t WS_WMIX = WS_W + 4 * SZ_LAYER_COMMON;
constexpr size_t SZ_QKV = (size_t)D * NQKV * 2;
constexpr size_t WM_A0_QKV = 0, WM_A0_O = SZ_QKV;
constexpr size_t WM_B_IN = WM_A0_O + SZ_DD, WM_B_G = WM_B_IN + 2 * SZ_DD, WM_B_O = WM_B_G + (size_t)4096 * 256 * 2;
constexpr size_t WM_C_IN = WM_B_O + SZ_DD, WM_C_GLU = WM_C_IN + SZ_DD;
constexpr size_t WM_A3_QKV = WM_C_GLU + 2 * SZ_DD, WM_A3_O = WM_A3_QKV + SZ_QKV;
constexpr size_t WM_END = WM_A3_O + SZ_DD;
constexpr size_t WS_ACT = ((WS_WMIX + WM_END + MiB - 1) / MiB) * MiB;
constexpr size_t WS_HN = WS_ACT;
constexpr size_t WS_PP = WS_HN + 32 * MiB;
constexpr size_t WS_PBF = WS_PP + 64 * MiB;
constexpr size_t WS_BIG = WS_PBF + 16 * MiB;
constexpr size_t WS_HB1 = WS_BIG + 192 * MiB;
constexpr size_t WS_SSQ0 = WS_HB1 + 32 * MiB, WS_SSQ1 = WS_SSQ0 + 1 * MiB;
constexpr size_t WS_END = WS_SSQ1 + 1 * MiB;
constexpr size_t BG_QKV = 0, BG_AO = 64 * MiB;
constexpr size_t BG_XB = 0, BG_BB = 64 * MiB, BG_GATE = 128 * MiB, BG_XC = 160 * MiB, BG_PE = 96 * MiB  ;
constexpr size_t BG_U = 0, BG_G = 64 * MiB, BG_ES = 128 * MiB;
constexpr size_t WS_SCAN = WS_PP;

constexpr int LDS_BYTES = 147456;

#if USE_XCD_BARRIER
#define XB_TMO      128
#define XB_XCNT(j)  (256  + 64 * (j))
#define XB_XSUB(j)  (1280 + 64 * (j))
#define XB_XGEN(j)  (2304 + 64 * (j))
#define XB_TOP      3328
#define XB_TOPGEN   3392
#define XCD_BAR_WORDS 3456
#define XB_SPIN_CAP (1u << 22)
__device__ __forceinline__ unsigned xb_ld(unsigned* p)              { return __hip_atomic_load(p, __ATOMIC_RELAXED, __HIP_MEMORY_SCOPE_AGENT); }
__device__ __forceinline__ unsigned xb_add(unsigned* p, unsigned v) { return __hip_atomic_fetch_add(p, v, __ATOMIC_RELAXED, __HIP_MEMORY_SCOPE_AGENT); }
__device__ __forceinline__ unsigned xb_xcc_id() { return (unsigned)__builtin_amdgcn_s_getreg((3 << 11) | 20) & 0xFu; }
#define XB_SPIN(cond, bar) do { unsigned _sp = 0; while (cond) { __builtin_amdgcn_s_sleep(1); \
    if ((++_sp & 255u) == 0u) { if (xb_ld(&(bar)[XB_TMO])) break; if (_sp > XB_SPIN_CAP) { atomicAdd(&(bar)[XB_TMO], 1u); break; } } } } while (0)
struct XcdBarrier { unsigned* bar; unsigned x; volatile LAS unsigned* st; };
__device__ __forceinline__ XcdBarrier xcd_barrier_post(unsigned* bar, volatile LAS unsigned* st) {
    XcdBarrier b; b.bar = bar; b.x = xb_xcc_id(); b.st = st;
    if (threadIdx.x == 0) (void)xb_add(&bar[XB_XCNT(b.x)], 1u);
    return b;
}
__device__ __forceinline__ void xcd_barrier_complete(unsigned* bar, unsigned x, unsigned& nloc, unsigned& nx) {
    const unsigned G = gridDim.x * gridDim.y * gridDim.z;
    unsigned sum, cnt, mine, sp = 0u;
    for (;;) {
        sum = 0u; cnt = 0u; mine = 0u;
#pragma unroll
        for (unsigned j = 0; j < 16; ++j) { const unsigned c = xb_ld(&bar[XB_XCNT(j)]); sum += c; cnt += (c > 0u) ? 1u : 0u; mine = (j == x) ? c : mine; }
        if (sum == G) break;
        __builtin_amdgcn_s_sleep(1);
        if ((++sp & 255u) == 0u) { if (xb_ld(&bar[XB_TMO])) break; if (sp > XB_SPIN_CAP) { atomicAdd(&bar[XB_TMO], 1u); break; } }
    }
    nloc = mine > 0u ? mine : 1u; nx = cnt > 0u ? cnt : 1u;
}
__device__ __forceinline__ void xcd_barrier(const XcdBarrier& b) {
    asm volatile("s_waitcnt vmcnt(0)" ::: "memory");
    __syncthreads();
    if (threadIdx.x == 0) {
        unsigned* bar = b.bar;
        __builtin_amdgcn_s_waitcnt(0);
        unsigned nloc = b.st[0], nx = b.st[1];
        if (nloc == 0u) { xcd_barrier_complete(bar, b.x, nloc, nx); b.st[0] = nloc; b.st[1] = nx; }
        const unsigned old = xb_add(&bar[XB_XSUB(b.x)], 1u);
        const unsigned gen = old / nloc;
        if (old + 1u == (gen + 1u) * nloc) {
            __builtin_amdgcn_fence(__ATOMIC_RELEASE, "agent");
            asm volatile("s_waitcnt vmcnt(0)" ::: "memory");
            const unsigned og = xb_add(&bar[XB_TOP], 1u);
            const unsigned tg = og / nx;
            if (og + 1u == (tg + 1u) * nx) xb_add(&bar[XB_TOPGEN], 1u);
            else XB_SPIN(xb_ld(&bar[XB_TOPGEN]) == tg, bar);
            __builtin_amdgcn_fence(__ATOMIC_ACQUIRE, "agent");
            xb_add(&bar[XB_XGEN(b.x)], 1u);
            asm volatile("s_waitcnt vmcnt(0)" ::: "memory");
        } else {
            XB_SPIN(xb_ld(&bar[XB_XGEN(b.x)]) == gen, bar);
            __builtin_amdgcn_fence(__ATOMIC_ACQUIRE, "agent");
            asm volatile("s_waitcnt vmcnt(0)" ::: "memory");
        }
    }
    __syncthreads();
}
#endif

__device__ __forceinline__ int rowmap(int mode, int ch) { return mode == 0 ? ch : (((ch >> 7) << 8) + (ch & 127) + (mode == 2 ? 128 : 0)); }
struct TrRegs { f32x4 v[16]; };
__device__ __forceinline__ void tr_load(TrRegs& R, const float* W, int ldw, int k0, int n0, int lane, const float* gain) {
    const int rr = lane >> 4, q4 = (lane & 15) * 4;
#pragma unroll
    for (int it = 0; it < 16; ++it) { const int kk = it * 4 + rr; R.v[it] = __builtin_nontemporal_load((const f32x4*)(W + (size_t)(k0 + kk) * ldw + n0 + q4));     if (gain) R.v[it] = R.v[it] * gain[k0 + kk]; }
}
__device__ __forceinline__ void tr_store(const TrRegs& R, bf16_t* WT, int ldt, int k0, int mode, int ch0, LAS float* scr, int lane) {
    const int rr = lane >> 4, q4 = (lane & 15) * 4;
#pragma unroll
    for (int it = 0; it < 16; ++it) { const int kk = it * 4 + rr; LAS float* sp = scr + kk * 65 + q4; sp[0] = R.v[it][0]; sp[1] = R.v[it][1]; sp[2] = R.v[it][2]; sp[3] = R.v[it][3]; }
    LDS_WAIT(); __builtin_amdgcn_wave_barrier();
    const int c = lane & 7;
#pragma unroll
    for (int it = 0; it < 8; ++it) { const int n = it * 8 + (lane >> 3); const LAS float* sp = scr + (8 * c) * 65 + n;
        u32x4 o; o.x = cvt_pk_bf16(sp[0 * 65], sp[1 * 65]); o.y = cvt_pk_bf16(sp[2 * 65], sp[3 * 65]); o.z = cvt_pk_bf16(sp[4 * 65], sp[5 * 65]); o.w = cvt_pk_bf16(sp[6 * 65], sp[7 * 65]);
        __builtin_nontemporal_store(o, (u32x4*)(WT + (size_t)rowmap(mode, ch0 + n) * ldt + k0 + 8 * c)); }
    LDS_WAIT(); __builtin_amdgcn_wave_barrier();
}
__device__ __forceinline__ void tr_tile(const float* W, int ldw, bf16_t* WT, int ldt, int k0, int n0, int mode, int ch0, LAS float* scr, int lane, const float* gain = nullptr) {
    TrRegs R; tr_load(R, W, ldw, k0, n0, lane, gain); tr_store(R, WT, ldt, k0, mode, ch0, scr, lane);
}
__device__ __forceinline__ void tr_matrix(const float* W, int K, int N, bf16_t* WT, int mode, int ch_base, LAS float* scr, int lane, int gw, int ngw, int& base, const float* gain = nullptr) {
    const int nb = N / 64, tiles = (K / 64) * nb;
    int start = gw - (base % ngw); if (start < 0) start += ngw;
    base += tiles;
    if (start >= tiles) return;
    TrRegs cur; tr_load(cur, W, N, (start / nb) * 64, (start % nb) * 64, lane, gain);
    for (int it = start; it < tiles; it += ngw) {
        const int kb = it / nb, n0 = (it % nb) * 64; const int itn = it + ngw;
        TrRegs nxt;
        if (itn < tiles) tr_load(nxt, W, N, (itn / nb) * 64, (itn % nb) * 64, lane, gain);
        tr_store(cur, WT, K, kb * 64, mode, ch_base + n0, scr, lane);
        if (itn < tiles) cur = nxt;
    }
}

__device__ __forceinline__ void prep_phase(const float* h, bf16_t* hb, float* ssq, int bid, int G) {
    const int tid = launder(threadIdx.x), lane = tid & 63, gw = bid * NWAVES + __builtin_amdgcn_readfirstlane(tid >> 6), ngw = G * NWAVES;
    for (int r = gw; r < T; r += ngw) {
        const f32x4* xr = (const f32x4*)(h + (size_t)r * D) + lane;
        f32x4 v[8]; float s = 0.f;
#pragma unroll
        for (int j = 0; j < 8; ++j) { v[j] = xr[64 * j]; s += (v[j][0] * v[j][0] + v[j][1] * v[j][1]) + (v[j][2] * v[j][2] + v[j][3] * v[j][3]); }
        s = wave_sum(s, lane);
        u32x2* o = (u32x2*)(hb + (size_t)r * D) + lane;
#pragma unroll
        for (int j = 0; j < 8; ++j) { u32x2 w; w.x = cvt_pk_bf16(v[j][0], v[j][1]); w.y = cvt_pk_bf16(v[j][2], v[j][3]); o[64 * j] = w; }
        if (lane < 16) ssq[(size_t)r * 16 + lane] = lane == 0 ? s : 0.f;
    }
}

constexpr int KS_STRIDE = 144;
constexpr int VT_STRIDE = 528;
constexpr int ATT_KS = 0, ATT_VT = 256 * KS_STRIDE, ATT_KP = ATT_VT + 64 * VT_STRIDE, ATT_END = ATT_KP + 1024;
__device__ __forceinline__ void attn_phase(LAS unsigned char* lds, const bf16_t* QKV, const int* positions, const float* qn, const float* kn, const float* sinks, bf16_t* AO, int G, int bid) {
    const int tid = launder(threadIdx.x), lane = tid & 63, wave = __builtin_amdgcn_readfirstlane(tid >> 6);
    const int fr = lane & 15, fq = lane >> 4;
    for (int unit = bid; unit < (T / 128) * 4; unit += G) {
        const int nb = ((unit & 7) >> 2) * 32 + (unit >> 3), hk = unit & 3;
        {
            const int kk = tid >> 1, half = tid & 1; const int tok = (nb - 1) * 128 + kk;
            u32x4 kraw[4], vraw[4];
            if (tok >= 0) {
                const u32x4* kp = (const u32x4*)(QKV + (size_t)tok * NQKV + 2048 + hk * 64 + half * 32);
                const u32x4* vp = (const u32x4*)(QKV + (size_t)tok * NQKV + 2304 + hk * 64 + half * 32);
#pragma unroll
                for (int i = 0; i < 4; ++i) { kraw[i] = kp[i]; vraw[i] = vp[i]; }
            } else {
#pragma unroll
                for (int i = 0; i < 4; ++i) { kraw[i] = (u32x4){0u, 0u, 0u, 0u}; vraw[i] = (u32x4){0u, 0u, 0u, 0u}; }
            }
            float ss = 0.f;
#pragma unroll
            for (int i = 0; i < 4; ++i)
#pragma unroll
                for (int j = 0; j < 4; ++j) { const float a = bflo(kraw[i][j]), b = bfhi(kraw[i][j]); ss += a * a + b * b; }
            ss += shx(ss, 1, lane);
            const float rstd = rsqrtf(ss * (1.0f / 64.0f) + EPS);
            LAS unsigned char* krow = lds + ATT_KS + kk * KS_STRIDE + half * 64;
#pragma unroll
            for (int i = 0; i < 4; ++i) { u32x4 w;
#pragma unroll
                for (int j = 0; j < 4; ++j) { const int d = half * 32 + i * 8 + j * 2; w[j] = cvt_pk_bf16(bflo(kraw[i][j]) * rstd * kn[d], bfhi(kraw[i][j]) * rstd * kn[d + 1]); }
                *(LAS u32x4*)(krow + i * 16) = w; }
#pragma unroll
            for (int i = 0; i < 4; ++i)
#pragma unroll
                for (int j = 0; j < 4; ++j) { const int d = half * 32 + i * 8 + j * 2;
                    *(LAS unsigned short*)(lds + ATT_VT + d * VT_STRIDE + kk * 2) = (unsigned short)(vraw[i][j] & 0xffffu);
                    *(LAS unsigned short*)(lds + ATT_VT + (d + 1) * VT_STRIDE + kk * 2) = (unsigned short)(vraw[i][j] >> 16); }
            if (half == 0) ((LAS int*)(lds + ATT_KP))[kk] = tok >= 0 ? positions[tok] : PAD_POS;
        }
        __syncthreads();
        const int h = hk * 8 + wave;
        const float slope = exp2f(-0.25f * (float)(h + 1));
        const float sink = sinks[h];
        u32x4 q0n = *(const u32x4*)(QKV + (size_t)(nb * 128 + fr) * NQKV + h * 64 + fq * 8);
        u32x4 q1n = *(const u32x4*)(QKV + (size_t)(nb * 128 + fr) * NQKV + h * 64 + 32 + fq * 8);
        int qposn = positions[nb * 128 + fr];
        for (int qt = 0; qt < 8; ++qt) {
            const int tq = nb * 128 + qt * 16 + fr;
            const int qpos = qposn;
            const u32x4 q0 = q0n, q1 = q1n;
            { const int tqn = nb * 128 + (qt < 7 ? qt + 1 : qt) * 16 + fr;
              q0n = *(const u32x4*)(QKV + (size_t)tqn * NQKV + h * 64 + fq * 8); q1n = *(const u32x4*)(QKV + (size_t)tqn * NQKV + h * 64 + 32 + fq * 8); qposn = positions[tqn]; }
            bf16x8 qf[2];
            {
                float ss = 0.f;
#pragma unroll
                for (int j = 0; j < 4; ++j) { const float a = bflo(q0[j]), b = bfhi(q0[j]), c = bflo(q1[j]), d = bfhi(q1[j]); ss += (a * a + b * b) + (c * c + d * d); }
                ss += shx(ss, 16, lane); ss += shx(ss, 32, lane);
                const float rs = rsqrtf(ss * (1.0f / 64.0f) + EPS) * 0.125f;
                u32x4 w0, w1;
#pragma unroll
                for (int j = 0; j < 4; ++j) { const int d = fq * 8 + j * 2;
                    w0[j] = cvt_pk_bf16(bflo(q0[j]) * rs * qn[d], bfhi(q0[j]) * rs * qn[d + 1]);
                    w1[j] = cvt_pk_bf16(bflo(q1[j]) * rs * qn[32 + d], bfhi(q1[j]) * rs * qn[32 + d + 1]); }
                qf[0] = __builtin_bit_cast(bf16x8, w0); qf[1] = __builtin_bit_cast(bf16x8, w1);
            }
            f32x4 s[16];
            float mx = sink;
            unsigned live = 0u;
#pragma unroll
            for (int kf = 0; kf < 16; ++kf) {
                const LAS int* kp = (const LAS int*)(lds + ATT_KP) + kf * 16 + fq * 4;
                int dist[4]; bool anyv = false;
#pragma unroll
                for (int i = 0; i < 4; ++i) { dist[i] = qpos - kp[i]; anyv = anyv || ((dist[i] >= 0) && (dist[i] < 128)); }
                if (__builtin_amdgcn_ballot_w64(anyv) == 0ull) { s[kf] = (f32x4){0.f, 0.f, 0.f, 0.f}; continue; }
                live |= 1u << kf;
                f32x4 a = (f32x4){0.f, 0.f, 0.f, 0.f};
#pragma unroll
                for (int ks = 0; ks < 2; ++ks) { const bf16x8 kfrag = *(const LAS bf16x8*)(lds + ATT_KS + (kf * 16 + fr) * KS_STRIDE + ks * 64 + fq * 16);
                    a = __builtin_amdgcn_mfma_f32_16x16x32_bf16(kfrag, qf[ks], a, 0, 0, 0); }
#pragma unroll
                for (int i = 0; i < 4; ++i) { const bool valid = (dist[i] >= 0) && (dist[i] < 128);
                    const float v = valid ? a[i] - slope * (float)dist[i] : -INFINITY; a[i] = v; mx = fmaxf(mx, v); }
                s[kf] = a;
            }
            mx = fmaxf(mx, shx(mx, 16, lane)); mx = fmaxf(mx, shx(mx, 32, lane));
            float sum = 0.f;
#pragma unroll
            for (int kf = 0; kf < 16; ++kf) {
                if (!((live >> kf) & 1u)) continue;
#pragma unroll
                for (int i = 0; i < 4; ++i) { const float p = __expf(s[kf][i] - mx); s[kf][i] = p; sum += p; }
            }
            sum += shx(sum, 16, lane); sum += shx(sum, 32, lane);
            const float inv = 1.0f / (sum + __expf(sink - mx));
            f32x4 o[4];
#pragma unroll
            for (int df = 0; df < 4; ++df) o[df] = (f32x4){0.f, 0.f, 0.f, 0.f};
#pragma unroll
            for (int w2 = 0; w2 < 8; ++w2) {
                if (!((live >> (2 * w2)) & 3u)) continue;
                u32x4 pw; pw.x = cvt_pk_bf16(s[2 * w2][0], s[2 * w2][1]); pw.y = cvt_pk_bf16(s[2 * w2][2], s[2 * w2][3]); pw.z = cvt_pk_bf16(s[2 * w2 + 1][0], s[2 * w2 + 1][1]); pw.w = cvt_pk_bf16(s[2 * w2 + 1][2], s[2 * w2 + 1][3]);
                const bf16x8 pf = __builtin_bit_cast(bf16x8, pw);
#pragma unroll
                for (int df = 0; df < 4; ++df) {
                    const LAS unsigned char* vr = lds + ATT_VT + (df * 16 + fr) * VT_STRIDE + (w2 * 32 + fq * 4) * 2;
                    const u32x2 v0 = *(const LAS u32x2*)vr, v1 = *(const LAS u32x2*)(vr + 32);
                    u32x4 vw; vw.x = v0.x; vw.y = v0.y; vw.z = v1.x; vw.w = v1.y;
                    o[df] = __builtin_amdgcn_mfma_f32_16x16x32_bf16(__builtin_bit_cast(bf16x8, vw), pf, o[df], 0, 0, 0);
                }
            }
#pragma unroll
            for (int df = 0; df < 4; ++df) { u32x2 w; w.x = cvt_pk_bf16(o[df][0] * inv, o[df][1] * inv); w.y = cvt_pk_bf16(o[df][2] * inv, o[df][3] * inv);
                *(u32x2*)(AO + (size_t)tq * D + h * 64 + df * 16 + fq * 4) = w; }
        }
        __syncthreads();
    }
}

__device__ __forceinline__ f32x4 ld_bf4(const bf16_t* p) { const u32x2 w = *(const u32x2*)p; return (f32x4){bflo(w.x), bfhi(w.x), bflo(w.y), bfhi(w.y)}; }
__device__ __forceinline__ void conv_phase(const bf16_t* XB, const float* cw, const float* cb, bf16_t* XC, int bid, int G) {
    const int gtid = bid * NTHR + launder(threadIdx.x), nthreads = G * NTHR;
    for (int item = gtid; item < 512 * 512; item += nthreads) {
        const int c = (item & 511) * 4, t0 = (item >> 9) * 16;
        const f32x4 w0 = *(const f32x4*)(cw + c), w1 = *(const f32x4*)(cw + D + c), w2 = *(const f32x4*)(cw + 2 * D + c), w3 = *(const f32x4*)(cw + 3 * D + c), bb = *(const f32x4*)(cb + c);
        const f32x4 z = (f32x4){0.f, 0.f, 0.f, 0.f};
        f32x4 xm3 = t0 >= 3 ? ld_bf4(XB + (size_t)(t0 - 3) * D + c) : z;
        f32x4 xm2 = t0 >= 2 ? ld_bf4(XB + (size_t)(t0 - 2) * D + c) : z;
        f32x4 xm1 = t0 >= 1 ? ld_bf4(XB + (size_t)(t0 - 1) * D + c) : z;
#pragma unroll
        for (int i = 0; i < 16; ++i) {
            const f32x4 x = ld_bf4(XB + (size_t)(t0 + i) * D + c);
            const f32x4 y = bb + w0 * xm3 + w1 * xm2 + w2 * xm1 + w3 * x;
            u32x2 w; w.x = cvt_pk_bf16(y[0], y[1]); w.y = cvt_pk_bf16(y[2], y[3]);
            *(u32x2*)(XC + (size_t)(t0 + i) * D + c) = w;
            xm3 = xm2; xm2 = xm1; xm1 = x;
        }
    }
}
constexpr int LRU_CH = 128, LRU_NC = T / LRU_CH;
__device__ __forceinline__ float lru_sp(float lam) { const float x = -lam; return -8.0f * ((x > 0.f ? x : 0.f) + log1pf(__expf(-fabsf(x)))); }
__device__ __forceinline__ void lru_ab(float r, float ii, float xcv, float sp, float& a, float& b) {
    const float la = r * sp;
    a = __expf(la);
    const float em = la > -0.01f ? -2.0f * la * (1.0f + la * (1.0f + 0.6666667f * la)) : 1.0f - a * a;
    b = __builtin_amdgcn_sqrtf(fmaxf(em, 0.f)) * ii * xcv;
}
constexpr int LB = 16;
__device__ __forceinline__ void lru_scan1(const bf16_t* Ab, const bf16_t* Bb, const bf16_t* XC, const float* lam, float* PE, int bid, int G) {
    const int gtid = bid * NTHR + launder(threadIdx.x), nthreads = G * NTHR;
    for (int item = gtid; item < LRU_NC * D; item += nthreads) {
        const int ch = item & (D - 1), c = item >> 11;
        const float sp = lru_sp(lam[ch]);
        const bf16_t* ap = Ab + (size_t)c * LRU_CH * D + ch; const bf16_t* bp = Bb + (size_t)c * LRU_CH * D + ch; const bf16_t* xp = XC + (size_t)c * LRU_CH * D + ch;
        float P = 1.f, hst = 0.f;
        float ra[LB], rx[LB], xv[LB];
#pragma unroll
        for (int i = 0; i < LB; ++i) { ra[i] = bf2f(ap[(size_t)i * D]); rx[i] = bf2f(bp[(size_t)i * D]); xv[i] = bf2f(xp[(size_t)i * D]); }
        for (int t = 0; t < LRU_CH; t += LB) {
            float ra2[LB], rx2[LB], xv2[LB];
            const int tn = (t + LB < LRU_CH) ? t + LB : t;
#pragma unroll
            for (int i = 0; i < LB; ++i) { ra2[i] = bf2f(ap[(size_t)(tn + i) * D]); rx2[i] = bf2f(bp[(size_t)(tn + i) * D]); xv2[i] = bf2f(xp[(size_t)(tn + i) * D]); }
#pragma unroll
            for (int i = 0; i < LB; ++i) { float a, b; lru_ab(ra[i], rx[i], xv[i], sp, a, b); hst = a * hst + b; P *= a; }
#pragma unroll
            for (int i = 0; i < LB; ++i) { ra[i] = ra2[i]; rx[i] = rx2[i]; xv[i] = xv2[i]; }
        }
        PE[(size_t)c * D + ch] = P; PE[(size_t)(LRU_NC + c) * D + ch] = hst;
    }
}
__device__ __forceinline__ void lru_scan2(const bf16_t* Ab, const bf16_t* Bb, const bf16_t* XC, const float* lam, const float* PE, const bf16_t* gate, bf16_t* Y, int bid, int G) {
    const int gtid = bid * NTHR + launder(threadIdx.x), nthreads = G * NTHR;
    for (int item = gtid; item < LRU_NC * D; item += nthreads) {
        const int ch = item & (D - 1), c = item >> 11;
        const float sp = lru_sp(lam[ch]);
        const size_t o0 = (size_t)c * LRU_CH * D + ch;
        const bf16_t* ap = Ab + o0; const bf16_t* bp = Bb + o0; const bf16_t* xp = XC + o0; const bf16_t* gp = gate + o0; bf16_t* yp = Y + o0;
        float ra[LB], rx[LB], xv[LB], g[LB];
#pragma unroll
        for (int i = 0; i < LB; ++i) { ra[i] = bf2f(ap[(size_t)i * D]); rx[i] = bf2f(bp[(size_t)i * D]); xv[i] = bf2f(xp[(size_t)i * D]); g[i] = bf2f(gp[(size_t)i * D]); }
        float hst = 0.f;
        {
            int cc = 0;
            for (; cc + 8 <= c; cc += 8) { float p[8], e[8];
#pragma unroll
                for (int i = 0; i < 8; ++i) { p[i] = PE[(size_t)(cc + i) * D + ch]; e[i] = PE[(size_t)(LRU_NC + cc + i) * D + ch]; }
#pragma unroll
                for (int i = 0; i < 8; ++i) hst = p[i] * hst + e[i]; }
            for (; cc < c; ++cc) hst = PE[(size_t)cc * D + ch] * hst + PE[(size_t)(LRU_NC + cc) * D + ch];
        }
        for (int t = 0; t < LRU_CH; t += LB) {
            float ra2[LB], rx2[LB], xv2[LB], g2[LB];
            const int tn = (t + LB < LRU_CH) ? t + LB : t;
#pragma unroll
            for (int i = 0; i < LB; ++i) { ra2[i] = bf2f(ap[(size_t)(tn + i) * D]); rx2[i] = bf2f(bp[(size_t)(tn + i) * D]); xv2[i] = bf2f(xp[(size_t)(tn + i) * D]); g2[i] = bf2f(gp[(size_t)(tn + i) * D]); }
#pragma unroll
            for (int i = 0; i < LB; ++i) { float a, b; lru_ab(ra[i], rx[i], xv[i], sp, a, b); hst = a * hst + b; const unsigned w = cvt_pk_bf16(hst * g[i], 0.f); yp[(size_t)(t + i) * D] = (bf16_t)(w & 0xffffu); }
#pragma unroll
            for (int i = 0; i < LB; ++i) { ra[i] = ra2[i]; rx[i] = rx2[i]; xv[i] = xv2[i]; g[i] = g2[i]; }
        }
    }
}

constexpr int S5_L = 256, S5_NC = T / S5_L;
constexpr int S5_BU_STRIDE = 528;
constexpr int S5_SB_STRIDE = 272;
constexpr int S5_OFF_SB = 16 * S5_BU_STRIDE, S5_OFF_U = S5_OFF_SB + 16 * S5_SB_STRIDE, S5_OFF_Z = S5_OFF_U + 1024, S5_WAVE_LDS = S5_OFF_Z + 512;
struct S5Params { const float *a_re, *a_im, *log_dt, *b_re, *b_im, *c_re, *c_im, *d_skip; };
struct S5Item { float abr, abi; bf16x8 bf[8]; };
__device__ __forceinline__ void s5_item_setup(const S5Params& P, int g, int lane, LAS unsigned char* wlds, S5Item& L) {
    LAS float* zt = (LAS float*)(wlds + S5_OFF_Z);
    {
        const float lr = P.a_re[g * 64 + lane], li = P.a_im[g * 64 + lane], dt = expf(P.log_dt[g]);
        const float mag = expf(lr * dt);
        L.abr = mag * cosf(li * dt); L.abi = mag * sinf(li * dt);
        const float n_re = L.abr - 1.0f, n_im = L.abi, den = lr * lr + li * li;
        zt[lane * 2] = (n_re * lr + n_im * li) / den; zt[lane * 2 + 1] = (n_im * lr - n_re * li) / den;
    }
    LDS_WAIT(); __builtin_amdgcn_wave_barrier();
    const int i0 = ((lane >> 4) & 1) * 8; const bool lo_half = lane >= 32;
#pragma unroll
    for (int f = 0; f < 8; ++f) {
        const int pp = 16 * f + (lane & 15), p = pp >> 1; const bool im = pp & 1;
        const float zr = zt[p * 2], zi = zt[p * 2 + 1];
        const f32x4* br = (const f32x4*)(P.b_re + (size_t)(g * 64 + p) * 16 + i0); const f32x4* bi = (const f32x4*)(P.b_im + (size_t)(g * 64 + p) * 16 + i0);
        float v[8];
#pragma unroll
        for (int q = 0; q < 2; ++q) { const f32x4 r = br[q], m = bi[q];
#pragma unroll
            for (int j = 0; j < 4; ++j) v[q * 4 + j] = im ? (zr * m[j] + zi * r[j]) : (zr * r[j] - zi * m[j]); }
        u32x4 w;
#pragma unroll
        for (int q = 0; q < 4; ++q) { const unsigned h2 = cvt_pk_bf16(v[2 * q], v[2 * q + 1]);
            const float r0 = v[2 * q] - bflo(h2), r1 = v[2 * q + 1] - bfhi(h2); w[q] = lo_half ? cvt_pk_bf16(r0, r1) : h2; }
        L.bf[f] = __builtin_bit_cast(bf16x8, w);
    }
}
__device__ __forceinline__ u32x2 s5_load_u(const bf16_t* U, int t0, int g, int lane) { if (t0 > T - 16) t0 = T - 16; return *(const u32x2*)(U + (size_t)(t0 + (lane >> 2)) * D + g * 16 + (lane & 3) * 4); }
__device__ __forceinline__ f32x4 s5_u_f32(const u32x2 w) { return (f32x4){bflo(w.x), bfhi(w.x), bflo(w.y), bfhi(w.y)}; }
__device__ __forceinline__ void s5_bu_tile(const S5Item& L, const f32x4 ucur, LAS unsigned char* wlds, int lane) {
    LAS float* ut = (LAS float*)(wlds + S5_OFF_U);
    *(LAS f32x4*)(ut + (lane >> 2) * 16 + (lane & 3) * 4) = ucur;
    LDS_WAIT(); __builtin_amdgcn_wave_barrier();
    const LAS f32x4* up = (const LAS f32x4*)(ut + (lane & 15) * 16 + ((lane >> 4) & 1) * 8);
    const f32x4 u0 = up[0], u1 = up[1];
    u32x4 w; w.x = cvt_pk_bf16(u0[0], u0[1]); w.y = cvt_pk_bf16(u0[2], u0[3]); w.z = cvt_pk_bf16(u1[0], u1[1]); w.w = cvt_pk_bf16(u1[2], u1[3]);
    const bf16x8 uf = __builtin_bit_cast(bf16x8, w);
#pragma unroll
    for (int f = 0; f < 8; ++f) {
        f32x4 d = (f32x4){0.f, 0.f, 0.f, 0.f};
        d = __builtin_amdgcn_mfma_f32_16x16x32_bf16(L.bf[f], uf, d, 0, 0, 0);
        *(LAS f32x4*)(wlds + (lane & 15) * S5_BU_STRIDE + (16 * f + (lane >> 4) * 4) * 4) = d;
    }
    LDS_WAIT(); __builtin_amdgcn_wave_barrier();
}
__device__ __forceinline__ void s5_scan1(LAS unsigned char* lds, const S5Params& P, const bf16_t* U, float* ES, int bid, int G) {
    const int tid = launder(threadIdx.x), lane = tid & 63, wave = __builtin_amdgcn_readfirstlane(tid >> 6), gw = bid * NWAVES + wave, ngw = G * NWAVES;
    LAS unsigned char* wlds = lds + wave * S5_WAVE_LDS;
    for (int item = gw; item < 128 * S5_NC; item += ngw) {
        const int g = item & 127, c = item >> 7;
        S5Item L; s5_item_setup(P, g, lane, wlds, L);
        float sre = 0.f, sim = 0.f;
        u32x2 uq0 = s5_load_u(U, c * S5_L, g, lane), uq1 = s5_load_u(U, c * S5_L + 16, g, lane), uq2 = s5_load_u(U, c * S5_L + 32, g, lane), uq3 = s5_load_u(U, c * S5_L + 48, g, lane);
        for (int t0 = c * S5_L; t0 < (c + 1) * S5_L; t0 += 16) {
            const f32x4 ucur = s5_u_f32(uq0);
            uq0 = uq1; uq1 = uq2; uq2 = uq3; uq3 = s5_load_u(U, t0 + 64, g, lane);
            s5_bu_tile(L, ucur, wlds, lane);
#pragma unroll
            for (int i = 0; i < 16; ++i) { const f32x2 bu = *(const LAS f32x2*)(wlds + i * S5_BU_STRIDE + lane * 8);
                const float nre = L.abr * sre - L.abi * sim + bu[0], nim = L.abr * sim + L.abi * sre + bu[1]; sre = nre; sim = nim; }
            LDS_WAIT(); __builtin_amdgcn_wave_barrier();
        }
        *(f32x2*)(ES + ((size_t)(g * S5_NC + c) * 64 + lane) * 2) = (f32x2){sre, sim};
    }
}
__device__ __forceinline__ void s5_scan2(LAS unsigned char* lds, const S5Params& P, const bf16_t* U, const float* ES, bf16_t* Gb, int bid, int G) {
    const int tid = launder(threadIdx.x), lane = tid & 63, wave = __builtin_amdgcn_readfirstlane(tid >> 6), gw = bid * NWAVES + wave, ngw = G * NWAVES;
    LAS unsigned char* wlds = lds + wave * S5_WAVE_LDS;
    LAS float* ut = (LAS float*)(wlds + S5_OFF_U);
    LAS unsigned char* sb = wlds + S5_OFF_SB;
    const int fr = lane & 15, fq = lane >> 4;
    for (int item = gw; item < 128 * S5_NC; item += ngw) {
        const int g = item & 127, c = item >> 7;
        S5Item L; s5_item_setup(P, g, lane, wlds, L);
        float pr = L.abr, pi = L.abi;
#pragma unroll
        for (int i = 0; i < 8; ++i) { const float nr = pr * pr - pi * pi, ni = 2.0f * pr * pi; pr = nr; pi = ni; }
        float sre = 0.f, sim = 0.f;
        {
            const float* ep = ES + ((size_t)(g * S5_NC) * 64 + lane) * 2; int cc = 0;
            for (; cc + 8 <= c; cc += 8) { f32x2 e[8];
#pragma unroll
                for (int i = 0; i < 8; ++i) e[i] = *(const f32x2*)(ep + (size_t)(cc + i) * 128);
#pragma unroll
                for (int i = 0; i < 8; ++i) { const float nre = pr * sre - pi * sim + e[i][0], nim = pr * sim + pi * sre + e[i][1]; sre = nre; sim = nim; } }
            for (; cc < c; ++cc) { const f32x2 e = *(const f32x2*)(ep + (size_t)cc * 128);
                const float nre = pr * sre - pi * sim + e[0], nim = pr * sim + pi * sre + e[1]; sre = nre; sim = nim; }
        }
        bf16x8 cf[4];
#pragma unroll
        for (int ks = 0; ks < 4; ++ks) { const int p0 = ks * 16 + fq * 4;
            const f32x4 cr = *(const f32x4*)(P.c_re + (size_t)(g * 16 + fr) * 64 + p0), ci = *(const f32x4*)(P.c_im + (size_t)(g * 16 + fr) * 64 + p0);
            u32x4 w; w.x = cvt_pk_bf16(cr[0], -ci[0]); w.y = cvt_pk_bf16(cr[1], -ci[1]); w.z = cvt_pk_bf16(cr[2], -ci[2]); w.w = cvt_pk_bf16(cr[3], -ci[3]);
            cf[ks] = __builtin_bit_cast(bf16x8, w); }
        const f32x4 dsk = *(const f32x4*)(P.d_skip + g * 16 + fq * 4);
        u32x2 uq0 = s5_load_u(U, c * S5_L, g, lane), uq1 = s5_load_u(U, c * S5_L + 16, g, lane), uq2 = s5_load_u(U, c * S5_L + 32, g, lane), uq3 = s5_load_u(U, c * S5_L + 48, g, lane);
        for (int t0 = c * S5_L; t0 < (c + 1) * S5_L; t0 += 16) {
            const f32x4 ucur = s5_u_f32(uq0);
            uq0 = uq1; uq1 = uq2; uq2 = uq3; uq3 = s5_load_u(U, t0 + 64, g, lane);
            s5_bu_tile(L, ucur, wlds, lane);
#pragma unroll
            for (int i = 0; i < 16; ++i) { const f32x2 bu = *(const LAS f32x2*)(wlds + i * S5_BU_STRIDE + lane * 8);
                const float nre = L.abr * sre - L.abi * sim + bu[0], nim = L.abr * sim + L.abi * sre + bu[1]; sre = nre; sim = nim;
                *(LAS unsigned*)(sb + i * S5_SB_STRIDE + lane * 4) = cvt_pk_bf16(sre, sim); }
            LDS_WAIT(); __builtin_amdgcn_wave_barrier();
            f32x4 y = (f32x4){0.f, 0.f, 0.f, 0.f};
#pragma unroll
            for (int ks = 0; ks < 4; ++ks) { const bf16x8 sf = *(const LAS bf16x8*)(sb + fr * S5_SB_STRIDE + ks * 64 + fq * 16);
                y = __builtin_amdgcn_mfma_f32_16x16x32_bf16(cf[ks], sf, y, 0, 0, 0); }
            const f32x4 uu = *(const LAS f32x4*)(ut + fr * 16 + fq * 4);
            u32x2 w; w.x = cvt_pk_bf16(gelu_tanh(y[0] + dsk[0] * uu[0]), gelu_tanh(y[1] + dsk[1] * uu[1])); w.y = cvt_pk_bf16(gelu_tanh(y[2] + dsk[2] * uu[2]), gelu_tanh(y[3] + dsk[3] * uu[3]));
            *(u32x2*)(Gb + (size_t)(t0 + fr) * D + g * 16 + fq * 4) = w;
            LDS_WAIT(); __builtin_amdgcn_wave_barrier();
        }
    }
}

struct Args { const void* in[60]; float* out; unsigned char* ws; };

__global__ void __launch_bounds__(NTHR, 2) mk_fwd(Args args) {
    extern __shared__ __attribute__((aligned(16))) unsigned char lds_raw[];
    LAS unsigned char* lds = (LAS unsigned char*)lds_raw;
    cg::grid_group grid = cg::this_grid();
    const int G = gridDim.x, bid = blockIdx.x;
    unsigned char* ws = args.ws;
    float* out = args.out;
#if USE_XCD_BARRIER
    volatile LAS unsigned* bst = (volatile LAS unsigned*)(lds + LDS_BYTES - 64);
    if (threadIdx.x < 16) bst[threadIdx.x] = 0u;
    __syncthreads();
    (void)xcd_barrier_post((unsigned*)(ws + WS_CTL), bst);
#define GRID_BAR() do { XcdBarrier b_; b_.bar = (unsigned*)(args.ws + WS_CTL); b_.x = xb_xcc_id(); b_.st = (volatile LAS unsigned*)(lds + LDS_BYTES - 64); xcd_barrier(b_); } while (0)
#else
#define GRID_BAR() grid.sync()
#endif
#define INF(i) ((const float*)args.in[(i)])

    bf16_t* HN = (bf16_t*)(ws + WS_HN); bf16_t* PP = (bf16_t*)(ws + WS_PP); bf16_t* PBF = (bf16_t*)(ws + WS_PBF);
    unsigned char* BIG = ws + WS_BIG;

    {
        const int tid = launder(threadIdx.x), lane = tid & 63, wave = __builtin_amdgcn_readfirstlane(tid >> 6);
        const int gw = bid * NWAVES + wave, ngw = G * NWAVES, gtid = bid * NTHR + tid, nthreads = G * NTHR;
        LAS float* scr = (LAS float*)(lds + wave * 16640);
        int base = 0;
        for (int l = 0; l < 4; ++l) {
            if (l == 1) continue;
            const int ib = l == 0 ? 3 : (l == 1 ? 15 : (l == 2 ? 31 : 48));
            const int ic = ib + (l == 1 ? 10 : (l == 2 ? 11 : 6));
            unsigned char* wl = ws + WS_W + (size_t)l * SZ_LAYER_COMMON;
            tr_matrix(INF(ic + 5), PLE, D, (bf16_t*)(wl + WOFF_PLE), 0, 0, scr, lane, gw, ngw, base);
            if (l == 3) continue;
            tr_matrix(INF(ic + 1), D, DFF, (bf16_t*)(wl + WOFF_UP), 0, 0, scr, lane, gw, ngw, base, INF(ic));
            tr_matrix(INF(ic + 2), DFF, D, (bf16_t*)(wl + WOFF_DOWN), 0, 0, scr, lane, gw, ngw, base);
            tr_matrix(INF(ic + 4), D, D, (bf16_t*)(wl + WOFF_PG), 0, 0, scr, lane, gw, ngw, base, INF(ic + 3));
        }
        unsigned char* wm = ws + WS_WMIX;
        tr_matrix(INF(4), D, NQKV, (bf16_t*)(wm + WM_A0_QKV), 0, 0, scr, lane, gw, ngw, base, INF(3));
        tr_matrix(INF(8), D, D, (bf16_t*)(wm + WM_A0_O), 0, 0, scr, lane, gw, ngw, base);
        tr_matrix(INF(49), D, NQKV, (bf16_t*)(wm + WM_A3_QKV), 0, 0, scr, lane, gw, ngw, base, INF(48));
        tr_matrix(INF(53), D, D, (bf16_t*)(wm + WM_A3_O), 0, 0, scr, lane, gw, ngw, base);
        tr_matrix(INF(32), D, D, (bf16_t*)(wm + WM_C_IN), 0, 0, scr, lane, gw, ngw, base, INF(31));
        {
            const float* W = INF(41); bf16_t* WT = (bf16_t*)(wm + WM_C_GLU);
            const int nbk = 2 * D / 64, tiles = (D / 64) * nbk;
            int start = gw - (base % ngw); if (start < 0) start += ngw;
            for (int it = start; it < tiles; it += ngw) { const int kb = it / nbk, n0 = (it % nbk) * 64; const bool gt = n0 >= D;
                tr_tile(W, 2 * D, WT, D, kb * 64, n0, gt ? 2 : 1, gt ? n0 - D : n0, scr, lane); }
            base += tiles;
        }
        const float* pin = INF(1);
        for (int i = gtid; i < 4 * T * PLE / 8; i += nthreads) { const f32x4 a = __builtin_nontemporal_load((const f32x4*)(pin + (size_t)i * 8)), b = __builtin_nontemporal_load((const f32x4*)(pin + (size_t)i * 8 + 4));
            u32x4 w; w.x = cvt_pk_bf16(a[0], a[1]); w.y = cvt_pk_bf16(a[2], a[3]); w.z = cvt_pk_bf16(b[0], b[1]); w.w = cvt_pk_bf16(b[2], b[3]); *(u32x4*)(PBF + (size_t)i * 8) = w; }
    }
    prep_phase(INF(0), HN, (float*)(ws + WS_SSQ0), bid, G);
    grid.sync();

    const int* positions = (const int*)args.in[2];
    bf16_t* HB0 = HN; bf16_t* HB1 = (bf16_t*)(ws + WS_HB1); float* SSQ0 = (float*)(ws + WS_SSQ0); float* SSQ1 = (float*)(ws + WS_SSQ1);
    LAS float* PTAB = (LAS float*)(lds + 131072);
    for (int l = 0; l < 4; ++l) {
        const int kind = l % 3;
        const int ib = l == 0 ? 3 : (l == 1 ? 15 : (l == 2 ? 31 : 48));
        const float* hin = l == 0 ? INF(0) : (const float*)out;
        unsigned char* wl = ws + WS_W + (size_t)l * SZ_LAYER_COMMON;
        unsigned char* wm = ws + WS_WMIX;

        if (kind == 0) {
            bf16_t* QKV = (bf16_t*)(BIG + BG_QKV); bf16_t* AO = (bf16_t*)(BIG + BG_AO);
            const bf16_t* Wqkv = (const bf16_t*)(wm + (l == 0 ? WM_A0_QKV : WM_A3_QKV)); const bf16_t* Wo = (const bf16_t*)(wm + (l == 0 ? WM_A0_O : WM_A3_O));
            { pg8::Gemm g{HB0, Wqkv, T, NQKV, D, D, D, 0, 0}; pg8::StaticOrder S; S.init(T, NQKV, G, bid); pg8::EpiBf16<0> E{QKV, NQKV, SSQ0}; pg8::gemm_phase(lds, g, S, E); }
            {
                int nbusy = (T / 256) * (NQKV / 256) - G; if (nbusy < 0 || nbusy >= G) nbusy = 0;
                if (bid >= nbusy) {
                    if (l == 0) {
                        const int tid = launder(threadIdx.x), lane = tid & 63, wave = __builtin_amdgcn_readfirstlane(tid >> 6);
                        const int gw = (bid - nbusy) * NWAVES + wave, ngw = (G - nbusy) * NWAVES;
                        LAS float* scr = (LAS float*)(lds + wave * 16640);
                        int base = 0; const int zz = launder_s(0);
                        unsigned char* wl1 = ws + WS_W + (size_t)1 * SZ_LAYER_COMMON;
                        tr_matrix(INF(zz + 16), D, 2 * D, (bf16_t*)(wm + WM_B_IN), 0, 0, scr, lane, gw, ngw, base, INF(zz + 15));
                        for (int nb = 0; nb < 8; ++nb) {
                            tr_matrix(INF(zz + 19) + (size_t)nb * 65536, 256, 256, (bf16_t*)(wm + WM_B_G), 1, nb * 256, scr, lane, gw, ngw, base);
                            tr_matrix(INF(zz + 21) + (size_t)nb * 65536, 256, 256, (bf16_t*)(wm + WM_B_G), 2, nb * 256, scr, lane, gw, ngw, base);
                        }
                        tr_matrix(INF(zz + 24), D, D, (bf16_t*)(wm + WM_B_O), 0, 0, scr, lane, gw, ngw, base);
                        tr_matrix(INF(zz + 26), D, DFF, (bf16_t*)(wl1 + WOFF_UP), 0, 0, scr, lane, gw, ngw, base, INF(zz + 25));
                        tr_matrix(INF(zz + 27), DFF, D, (bf16_t*)(wl1 + WOFF_DOWN), 0, 0, scr, lane, gw, ngw, base);
                        tr_matrix(INF(zz + 29), D, D, (bf16_t*)(wl1 + WOFF_PG), 0, 0, scr, lane, gw, ngw, base, INF(zz + 28));
                        tr_matrix(INF(zz + 30), PLE, D, (bf16_t*)(wl1 + WOFF_PLE), 0, 0, scr, lane, gw, ngw, base);
                    } else {
                        pg8::Gemm g{PBF + (size_t)l * T * PLE, (const bf16_t*)(wl + WOFF_PLE), T, D, PLE, PLE, PLE, 0, 0}; pg8::StaticOrder S; S.init(T, D, G - nbusy, bid - nbusy); pg8::EpiBf16<0> E{PP, D, nullptr}; pg8::gemm_phase(lds, g, S, E);
                        const int tid = launder(threadIdx.x), lane = tid & 63, wave = __builtin_amdgcn_readfirstlane(tid >> 6);
                        const int gw = (bid - nbusy) * NWAVES + wave, ngw = (G - nbusy) * NWAVES;
                        LAS float* scr = (LAS float*)(lds + wave * 16640);
                        int base = 0; const int zz = launder_s(0);
                        tr_matrix(INF(zz + 55), D, DFF, (bf16_t*)(wl + WOFF_UP), 0, 0, scr, lane, gw, ngw, base, INF(zz + 54));
                        tr_matrix(INF(zz + 56), DFF, D, (bf16_t*)(wl + WOFF_DOWN), 0, 0, scr, lane, gw, ngw, base);
                        tr_matrix(INF(zz + 58), D, D, (bf16_t*)(wl + WOFF_PG), 0, 0, scr, lane, gw, ngw, base, INF(zz + 57));
                    }
                }
            }
            GRID_BAR();
            attn_phase(lds, QKV, positions, INF(ib + 2), INF(ib + 3), INF(ib + 4), AO, G, bid);
            GRID_BAR();
            { pg8::Gemm g{AO, Wo, T, D, D, D, D, 0, 0}; pg8::StaticOrder S; S.init(T, D, G, bid); pg8::EpiResidual E{hin, out, HB0, SSQ0, PTAB, nullptr}; pg8::gemm_phase(lds, g, S, E); }
            GRID_BAR();
        } else if (kind == 1) {
            bf16_t* XB = (bf16_t*)(BIG + BG_XB); bf16_t* AB = (bf16_t*)(BIG + BG_XB + 32 * MiB); bf16_t* BB = (bf16_t*)(BIG + BG_BB); bf16_t* GATE = (bf16_t*)(BIG + BG_GATE); bf16_t* XC = (bf16_t*)(BIG + BG_XC); bf16_t* Y = HB1;
            float* PE = (float*)(ws + WS_SCAN);
            { pg8::Gemm g{HB0, (const bf16_t*)(wm + WM_B_IN), T, 2 * D, D, D, D, 0, 0}; pg8::StaticOrder S; S.init(T, 2 * D, G, bid); pg8::EpiLruIn E{XB, GATE, SSQ0}; pg8::gemm_phase(lds, g, S, E); }
            GRID_BAR();
            conv_phase(XB, INF(ib + 2), INF(ib + 3), XC, bid, G);
            GRID_BAR();
            { pg8::Gemm g{XC, (const bf16_t*)(wm + WM_B_G), T, 2 * D, 256, D, 256, 1, 256}; pg8::StaticOrder S; S.init(T, 2 * D, G, bid);
              pg8::EpiLruGate E{INF(ib + 5), INF(ib + 7), AB, BB}; pg8::gemm_phase(lds, g, S, E); }
            GRID_BAR();
            lru_scan1(AB, BB, XC, INF(ib + 8), PE, bid, G);
            GRID_BAR();
            lru_scan2(AB, BB, XC, INF(ib + 8), PE, GATE, Y, bid, G);
            GRID_BAR();
            { pg8::Gemm g{Y, (const bf16_t*)(wm + WM_B_O), T, D, D, D, D, 0, 0}; pg8::StaticOrder S; S.init(T, D, G, bid); pg8::EpiResidual E{hin, out, HB0, SSQ0, PTAB, nullptr}; pg8::gemm_phase(lds, g, S, E); }
            GRID_BAR();
        } else {
            bf16_t* U = (bf16_t*)(BIG + BG_U); bf16_t* Gb = (bf16_t*)(BIG + BG_G); float* ES = (float*)(BIG + BG_ES);
            S5Params SP{INF(ib + 2), INF(ib + 3), INF(ib + 4), INF(ib + 5), INF(ib + 6), INF(ib + 7), INF(ib + 8), INF(ib + 9)};
            { pg8::Gemm g{HB0, (const bf16_t*)(wm + WM_C_IN), T, D, D, D, D, 0, 0}; pg8::StaticOrder S; S.init(T, D, G, bid); pg8::EpiBf16<0> E{U, D, SSQ0}; pg8::gemm_phase(lds, g, S, E); }
            GRID_BAR();
            s5_scan1(lds, SP, U, ES, bid, G);
            GRID_BAR();
            s5_scan2(lds, SP, U, ES, Gb, bid, G);
            GRID_BAR();
            { pg8::Gemm g{Gb, (const bf16_t*)(wm + WM_C_GLU), T, 2 * D, D, D, D, 0, 0}; pg8::StaticOrder S; S.init(T, 2 * D, G, bid); pg8::EpiGlu E{out, HB0, SSQ0, PTAB}; pg8::gemm_phase(lds, g, S, E); }
            GRID_BAR();
        }
        {
            bf16_t* UP = (bf16_t*)BIG;
            { pg8::Gemm g{HB0, (const bf16_t*)(wl + WOFF_UP), T, DFF, D, D, D, 0, 0}; pg8::StaticOrder S; S.init(T, DFF, G, bid); pg8::EpiBf16<2> E{UP, DFF, nullptr}; pg8::gemm_phase(lds, g, S, E); }
            if (l != 3) { pg8::Gemm g{PBF + (size_t)l * T * PLE, (const bf16_t*)(wl + WOFF_PLE), T, D, PLE, PLE, PLE, 0, 0}; pg8::StaticOrder S; S.init(T, D, G, bid); pg8::EpiBf16<0> E{PP, D, nullptr}; pg8::gemm_phase(lds, g, S, E); }
            GRID_BAR();
            { pg8::Gemm g{UP, (const bf16_t*)(wl + WOFF_DOWN), T, D, DFF, DFF, DFF, 0, 0}; pg8::StaticOrder S; S.init(T, D, G, bid); pg8::EpiResidual E{out, out, HB1, SSQ1, PTAB, SSQ0}; pg8::gemm_phase(lds, g, S, E); }
            GRID_BAR();
        }
        if (l < 3) { pg8::Gemm g{HB1, (const bf16_t*)(wl + WOFF_PG), T, D, D, D, D, 0, 0}; pg8::StaticOrder S; S.init(T, D, G, bid); pg8::EpiPle<false> E{PP, out, SSQ1, HB0, SSQ0, PTAB}; pg8::gemm_phase(lds, g, S, E); }
        else       { pg8::Gemm g{HB1, (const bf16_t*)(wl + WOFF_PG), T, D, D, D, D, 0, 0}; pg8::StaticOrder S; S.init(T, D, G, bid); pg8::EpiPle<true> E{PP, out, SSQ1, HB0, SSQ0, PTAB}; pg8::gemm_phase(lds, g, S, E); }
        if (l < 3) GRID_BAR();
    }
}

extern "C" void kernel_launch(void* const* d_in, const int* in_sizes, int n_in, void* d_out, int out_size, void* d_ws, size_t ws_size, hipStream_t stream) {
    static int grid = 0;
    if (grid == 0) {
        if (n_in != 60 || out_size != T * D || ws_size < WS_END) { fprintf(stderr, "kernel_launch: unexpected shapes: n_in %d out %d ws %zu (need %zu)\n", n_in, out_size, ws_size, (size_t)WS_END); grid = -1; return; }
        int dev = 0, cus = 0, per_cu = 0;
        if (hipGetDevice(&dev) != hipSuccess || hipDeviceGetAttribute(&cus, hipDeviceAttributeMultiprocessorCount, dev) != hipSuccess) { grid = -1; return; }
        if (hipFuncSetAttribute((const void*)mk_fwd, hipFuncAttributeMaxDynamicSharedMemorySize, LDS_BYTES) != hipSuccess) { fprintf(stderr, "kernel_launch: hipFuncSetAttribute failed\n"); grid = -1; return; }
        if (hipOccupancyMaxActiveBlocksPerMultiprocessor(&per_cu, (const void*)mk_fwd, NTHR, LDS_BYTES) != hipSuccess || per_cu < 1) { fprintf(stderr, "kernel_launch: occupancy query says %d\n", per_cu); per_cu = 1; }
        (void)hipGetLastError();
        grid = cus * 1;
    }
    if (grid < 0) return;
    (void)hipMemsetAsync((char*)d_ws + WS_CTL, 0, CTL_ZERO_BYTES, stream);
    Args a{};
    for (int i = 0; i < 60; ++i) a.in[i] = d_in[i];
    a.out = (float*)d_out; a.ws = (unsigned char*)d_ws;
    void* params[] = {&a};
    hipError_t e = hipLaunchCooperativeKernel((const void*)mk_fwd, dim3(grid), dim3(NTHR), params, LDS_BYTES, stream);
    if (e != hipSuccess) fprintf(stderr, "kernel_launch: cooperative launch failed: %s (grid %d)\n", hipGetErrorString(e), grid);
}
```
